# Optimizing an MI355X kernel written in HIP

```python
import jax, jax.numpy as jnp
from jax import lax
import numpy as np

D_MODEL = 1024
BATCH = 1
SEQ = 16384
DEPTH = 1
DEC_BATCH = 16
DEC_SEQ = 2048
PAST_LEN = 128

GRID_W = 64
N_MEM = 256
F_GROUPS = 4
F_CH = 64
F_WIDTH = F_GROUPS * F_CH
HEAD_DIM = 128
N_Q_HEADS = 6
N_KV_HEADS = 2
Q_PER_KV = N_Q_HEADS // N_KV_HEADS
Q_WIDTH = N_Q_HEADS * HEAD_DIM
KV_WIDTH = N_KV_HEADS * HEAD_DIM
MIX_WIDTH = F_WIDTH + Q_WIDTH
IN_WIDTH = F_WIDTH + Q_WIDTH + 2 * KV_WIDTH
Q_BLOCK = 128
ROPE_AXIS_DIM = HEAD_DIM // 2
ROPE_THETA = 10000.0
X_HEADS = 4
X_HEAD_DIM = D_MODEL // X_HEADS
D_FF = 4 * D_MODEL
EPS = 1e-6

kernel_name = "hybrid_fourier_gqa_axial_encoder"


def rms_norm(x, g):
    xf = x.astype(jnp.float32)
    y = xf * lax.rsqrt(jnp.mean(xf * xf, axis=-1, keepdims=True) + EPS)
    return (y * g.astype(jnp.float32)).astype(x.dtype)


def axial_angles(n_tok):
    rows = n_tok // GRID_W
    r = jnp.repeat(jnp.arange(rows, dtype=jnp.float32), GRID_W)
    c = jnp.tile(jnp.arange(GRID_W, dtype=jnp.float32), rows)
    inv_freq = 1.0 / (ROPE_THETA ** (jnp.arange(0, ROPE_AXIS_DIM, 2, dtype=jnp.float32) / ROPE_AXIS_DIM))
    ang_r = r[:, None] * inv_freq[None, :]
    ang_c = c[:, None] * inv_freq[None, :]
    return (jnp.cos(ang_r)[:, None, :], jnp.sin(ang_r)[:, None, :],
            jnp.cos(ang_c)[:, None, :], jnp.sin(ang_c)[:, None, :])


def rotate(xp, cos, sin):
    half = xp.shape[-1] // 2
    a, b = xp[..., :half], xp[..., half:]
    return jnp.concatenate([a * cos - b * sin, b * cos + a * sin], axis=-1)


def axial_rope(x, angles):
    cr, sr, cc, sc = angles
    xf = x.astype(jnp.float32)
    out = jnp.concatenate([rotate(xf[..., :ROPE_AXIS_DIM], cr, sr),
                           rotate(xf[..., ROPE_AXIS_DIM:], cc, sc)], axis=-1)
    return out.astype(x.dtype)


def fourier_mixer(zf, w_f):
    b, s, _ = zf.shape
    zg = zf.reshape(b, s, F_GROUPS, F_CH).astype(jnp.float32)
    fr = jnp.fft.fft2(zg, axes=(1, 3), norm="ortho").real.astype(zf.dtype)
    out = jnp.einsum('bsgc,gcd->bsgd', fr, w_f)
    return out.reshape(b, s, F_WIDTH)


def block_gqa(q, k, v):
    b, s, _, d = q.shape
    nb = s // Q_BLOCK
    scale = 1.0 / np.sqrt(d).astype(np.float32)
    qb = q.reshape(b, nb, Q_BLOCK, N_KV_HEADS, Q_PER_KV, d).transpose(1, 0, 2, 3, 4, 5)
    kf = k.astype(jnp.float32)

    def one_block(qblk):
        sc = jnp.einsum('bqkgd,bskd->bkgqs', qblk.astype(jnp.float32), kf) * scale
        p = jax.nn.softmax(sc, axis=-1).astype(v.dtype)
        return jnp.einsum('bkgqs,bskd->bqkgd', p, v)

    ob = lax.map(one_block, qb)
    return ob.transpose(1, 0, 2, 3, 4, 5).reshape(b, s, N_Q_HEADS * d)


def memory_cross_attention(h, mem_n, w_cq, w_ckv, g_cq, g_ck, w_co):
    b, s, _ = h.shape
    m = mem_n.shape[1]
    q = rms_norm((h @ w_cq).reshape(b, s, X_HEADS, X_HEAD_DIM), g_cq)
    kv = mem_n @ w_ckv
    k = rms_norm(kv[..., :D_MODEL].reshape(b, m, X_HEADS, X_HEAD_DIM), g_ck)
    v = kv[..., D_MODEL:].reshape(b, m, X_HEADS, X_HEAD_DIM)
    scale = 1.0 / np.sqrt(X_HEAD_DIM).astype(np.float32)
    sc = jnp.einsum('bqhd,bmhd->bhqm', q.astype(jnp.float32), k.astype(jnp.float32)) * scale
    p = jax.nn.softmax(sc, axis=-1).astype(v.dtype)
    o = jnp.einsum('bhqm,bmhd->bqhd', p, v).reshape(b, s, D_MODEL)
    return o @ w_co


def encoder_layer(x, mem, angles, g_mix, w_in, w_fourier, g_q, g_k, w_out,
                  g_cross, g_mem, w_cq, w_ckv, g_cq, g_ck, w_co, g_mlp, w_up, w_down):
    b, s, _ = x.shape
    h = rms_norm(x, g_mix)
    z = h @ w_in
    zf = z[..., :F_WIDTH]
    zq = z[..., F_WIDTH:F_WIDTH + Q_WIDTH]
    zk = z[..., F_WIDTH + Q_WIDTH:F_WIDTH + Q_WIDTH + KV_WIDTH]
    zv = z[..., F_WIDTH + Q_WIDTH + KV_WIDTH:]
    f_out = fourier_mixer(zf, w_fourier)
    q = axial_rope(rms_norm(zq.reshape(b, s, N_Q_HEADS, HEAD_DIM), g_q), angles)
    k = axial_rope(rms_norm(zk.reshape(b, s, N_KV_HEADS, HEAD_DIM), g_k), angles)
    v = zv.reshape(b, s, N_KV_HEADS, HEAD_DIM)
    a_out = block_gqa(q, k, v)
    x = x + jnp.concatenate([f_out, a_out], axis=-1) @ w_out
    x = x + memory_cross_attention(rms_norm(x, g_cross), rms_norm(mem, g_mem),
                                   w_cq, w_ckv, g_cq, g_ck, w_co)
    u = jax.nn.relu(rms_norm(x, g_mlp) @ w_up)
    x = x + (u * u) @ w_down
    return x


def setup_inputs(seed: int = 0) -> dict:
    key = jax.random.key(seed)
    ks = jax.random.split(key, 24)
    f32 = jnp.float32

    def w(k, shape, fan_in, mult=1.0):
        return jax.random.normal(k, shape, f32) * (mult * fan_in ** -0.5)

    def gain(k, shape):
        return 1.0 + 0.02 * jax.random.normal(k, shape, f32)

    L = DEPTH
    return {
        "x_prompt": jax.random.normal(ks[0], (BATCH, SEQ, D_MODEL), f32),
        "x_sample": jax.random.normal(ks[1], (DEC_BATCH, DEC_SEQ, D_MODEL), f32),
        "mem_prompt": jax.random.normal(ks[2], (BATCH, N_MEM, D_MODEL), f32),
        "mem_sample": jax.random.normal(ks[3], (DEC_BATCH, N_MEM, D_MODEL), f32),
        "g_mix": gain(ks[4], (L, D_MODEL)),
        "w_in": w(ks[5], (L, D_MODEL, IN_WIDTH), D_MODEL),
        "w_fourier": w(ks[6], (L, F_GROUPS, F_CH, F_CH), F_CH),
        "g_q": gain(ks[7], (L, HEAD_DIM)),
        "g_k": gain(ks[8], (L, HEAD_DIM)),
        "w_out": w(ks[9], (L, MIX_WIDTH, D_MODEL), MIX_WIDTH, 0.5),
        "g_cross": gain(ks[10], (L, D_MODEL)),
        "g_mem": gain(ks[11], (L, D_MODEL)),
        "w_cq": w(ks[12], (L, D_MODEL, D_MODEL), D_MODEL),
        "w_ckv": w(ks[13], (L, D_MODEL, 2 * D_MODEL), D_MODEL),
        "g_cq": gain(ks[14], (L, X_HEAD_DIM)),
        "g_ck": gain(ks[15], (L, X_HEAD_DIM)),
        "w_co": w(ks[16], (L, D_MODEL, D_MODEL), D_MODEL, 0.5),
        "g_mlp": gain(ks[17], (L, D_MODEL)),
        "w_up": w(ks[18], (L, D_MODEL, D_FF), D_MODEL),
        "w_down": w(ks[19], (L, D_FF, D_MODEL), D_FF, 0.5),
    }


def reference(x_prompt, x_sample, mem_prompt, mem_sample, g_mix, w_in, w_fourier, g_q, g_k, w_out,
              g_cross, g_mem, w_cq, w_ckv, g_cq, g_ck, w_co, g_mlp, w_up, w_down):
    ang_p = axial_angles(x_prompt.shape[1])
    ang_s = axial_angles(x_sample.shape[1])
    yp = x_prompt
    ys = x_sample
    for l in range(DEPTH):
        p = (g_mix[l], w_in[l], w_fourier[l], g_q[l], g_k[l], w_out[l], g_cross[l], g_mem[l],
             w_cq[l], w_ckv[l], g_cq[l], g_ck[l], w_co[l], g_mlp[l], w_up[l], w_down[l])
        yp = encoder_layer(yp, mem_prompt, ang_p, *p)
        ys = encoder_layer(ys, mem_sample, ang_s, *p)
    return (yp, ys)
```

```cpp
#include <hip/hip_runtime.h>
#include <hip/hip_cooperative_groups.h>
#include <cstdio>
#include <cstdint>
namespace cg = cooperative_groups;

#define LAS __attribute__((address_space(3)))
typedef unsigned short bf16_t;
typedef short bf16x8 __attribute__((ext_vector_type(8)));
typedef short s16x4 __attribute__((ext_vector_type(4)));
typedef float f32x4 __attribute__((ext_vector_type(4)));
typedef float f32x16 __attribute__((ext_vector_type(16)));
typedef unsigned u32x4 __attribute__((ext_vector_type(4)));

constexpr int DM = 1024, TP = 16384, TS = 32768, TT = TP + TS, SS_LEN = 2048, NMEMROWS = 17 * 256;
constexpr int NIN = 1792;
constexpr float EPS = 1e-6f;
constexpr size_t MiB = 1u << 20, KiB = 1024;
constexpr size_t WS_SS2 = 0, WS_SS3 = 196608;
constexpr size_t WS_ROPE = 512 * KiB;
constexpr size_t WS_F1P = 640 * KiB, WS_F2P = 768 * KiB, WS_F1S = 832 * KiB, WS_F2S = 840 * KiB;
constexpr size_t WS_WIN = 1 * MiB, WS_WOUT = WS_WIN + 3584 * KiB, WS_WCQ = WS_WOUT + 2 * MiB, WS_WCKV = WS_WCQ + 2 * MiB,
                 WS_WCO = WS_WCKV + 4 * MiB, WS_WUP = WS_WCO + 2 * MiB, WS_WDN = WS_WUP + 8 * MiB;
constexpr size_t WS_MN = 31 * MiB, WS_KC = WS_MN + 8704 * KiB, WS_VT = WS_KC + 8704 * KiB;
constexpr size_t SLOT_A = 64 * MiB, SLOT_B = 160 * MiB, SLOT_C = 256 * MiB, SLOT_D = 352 * MiB, SLOT_E = 448 * MiB;
constexpr size_t WS_XN1 = SLOT_A, WS_PB = SLOT_B, WS_TMP = SLOT_B + 48 * MiB, WS_QB = SLOT_C, WS_KB = SLOT_E  , WS_VB = SLOT_E;
constexpr size_t WS_MIX = SLOT_A, WS_XB2 = SLOT_B, WS_QC = SLOT_C, WS_PC = SLOT_D, WS_OC = SLOT_A, WS_XB3 = SLOT_B, WS_H = SLOT_C;
constexpr size_t WS_BAR = 896 * KiB, BAR_BYTES = 16 * KiB;
constexpr size_t WS_NEED = 512 * MiB;
constexpr int LDS_BYTES = 147456, ELDS_OFF = 131072, MISC_OFF = ELDS_OFF + 12288;

__device__ __forceinline__ unsigned cvt_pk_bf16(float lo, float hi) { unsigned r; asm volatile("v_cvt_pk_bf16_f32 %0, %1, %2" : "=v"(r) : "v"(lo), "v"(hi)); return r; }
__device__ __forceinline__ unsigned f2bf(float f) { unsigned u = __builtin_bit_cast(unsigned, f); return (u + 0x7fffu + ((u >> 16) & 1u)) >> 16; }
__device__ __forceinline__ unsigned pk2(float lo, float hi) { return f2bf(lo) | (f2bf(hi) << 16); }
__device__ __forceinline__ float wave_sum(float v) {
#pragma unroll
    for (int o = 1; o < 64; o <<= 1) v += __shfl_xor(v, o);
    return v;
}
__device__ __forceinline__ int opaque_tid(int wave) { int t; asm volatile("v_mbcnt_lo_u32_b32 %0, -1, 0\n\tv_mbcnt_hi_u32_b32 %0, -1, %0\n\tv_or_b32 %0, %1, %0" : "=&v"(t) : "s"(wave << 6)); return t; }
__device__ __forceinline__ unsigned char* ws_launder(unsigned char* p) { asm volatile("" : "+s"(p)); return p; }
#define LDS_WAIT() asm volatile("s_waitcnt lgkmcnt(0)" ::: "memory")
#define RAW_BAR() do { asm volatile("s_waitcnt lgkmcnt(0)" ::: "memory"); __builtin_amdgcn_s_barrier(); asm volatile("" ::: "memory"); } while (0)

namespace pg8 {
constexpr int BM = 256, BK = 64, HALF = 128, HTB = HALF * BK * 2, STAGE_BYTES = 8 * HTB, NXCD = 8, WGM = 8;
__host__ __device__ __forceinline__ int lds_byte(int r, int c) { const int st = (r >> 4) * 2 + (c >> 5), rr = r & 15, cc = c & 31, ob = rr * 64 + cc * 2; return st * 1024 + (ob ^ (((ob >> 9) & 1) << 5)); }
__host__ __device__ __forceinline__ void stage_rc(int b, int& R, int& C) { const int st = b / 1024, sb = b % 1024, swz = sb ^ (((sb >> 9) & 1) << 5); R = (st >> 1) * 16 + swz / 64; C = (st & 1) * 32 + (swz % 64) / 2; }
__host__ __device__ __forceinline__ int perm32(int rho) { const int n = rho >> 4, i = rho & 15; return 8 * (i >> 2) + 4 * n + (i & 3); }

struct Unit { int pm, pn, gid; };
__device__ __forceinline__ void map_tile(int wgid, int nM, int nN, int& pm, int& pn) {
    const int nwg = nM * nN;
    { const int q = nwg / NXCD, r = nwg % NXCD, xcd = wgid % NXCD, off = wgid / NXCD; wgid = (xcd < r ? xcd * (q + 1) : r * (q + 1) + (xcd - r) * q) + off; }
    const int nig = WGM * nN, gid = wgid / nig, fm = gid * WGM, gsz = (nM - fm) < WGM ? (nM - fm) : WGM;
    pm = fm + ((wgid % nig) % gsz); pn = (wgid % nig) / gsz;
}
template <class Epi, class Pol>
__device__ __forceinline__ void gemm_phase(const int wave_id, LAS unsigned char* lds, LAS unsigned char* elds, const Pol& S, const Epi& E, const int K, const int lda, const int ldb) {
    const int tid = opaque_tid(wave_id), wid = __builtin_amdgcn_readfirstlane(tid >> 6), lane = tid & 63, wr = wid >> 2, wc = wid & 3, fr = lane & 15, fq = lane >> 4;
    int nt = K / BK; asm volatile("" : "+s"(nt));
    unsigned voffA[2], voffB[2];
#pragma unroll
    for (int i = 0; i < 2; ++i) { int R, C; stage_rc(tid * 16 + i * 8192, R, C); const int Rb = (R & ~31) + perm32(R & 31);
        voffA[i] = (unsigned)(R * lda + C) * 2u; voffB[i] = (unsigned)(Rb * ldb + C) * 2u; }
    const size_t kstep = (size_t)(BK * 2);
    const size_t hA = (size_t)HALF * lda * 2, hB = (size_t)HALF * ldb * 2;
    const unsigned ldsw = (unsigned)wid * 1024u;
    const int aoff = lds_byte(wr * 64 + fr, fq * 8), boff = lds_byte(wc * 32 + fr, fq * 8);
#define PG8_SA(b, h) (((b) * 2 + (h)) * HTB)
#define PG8_SB(b, h) ((4 + (b) * 2 + (h)) * HTB)
#define PG8_STAGE(bufoff, gbase, voff) do { _Pragma("unroll") for (int _i = 0; _i < 2; ++_i) \
        __builtin_amdgcn_global_load_lds((const unsigned*)((const char*)(gbase) + (voff)[_i]), (LAS unsigned*)(lds + (bufoff) + ldsw + _i * 8192), 16, 0, 0); } while (0)
#define PG8_LDA(dst, b, h) do { _Pragma("unroll") for (int m = 0; m < 4; ++m) _Pragma("unroll") for (int k = 0; k < 2; ++k) dst[m][k] = *(const LAS bf16x8*)(lds + PG8_SA(b, h) + aoff + m * 2048 + k * 1024); } while (0)
#define PG8_LDB(dst, b, h) do { _Pragma("unroll") for (int n = 0; n < 2; ++n) _Pragma("unroll") for (int k = 0; k < 2; ++k) dst[n][k] = *(const LAS bf16x8*)(lds + PG8_SB(b, h) + boff + n * 2048 + k * 1024); } while (0)
#define PG8_MMA(ai, bj, At, Bt) do { __builtin_amdgcn_s_setprio(1); _Pragma("unroll") for (int m = 0; m < 4; ++m) _Pragma("unroll") for (int n = 0; n < 2; ++n) _Pragma("unroll") for (int k = 0; k < 2; ++k) \
        acc[ai][bj][m][n] = __builtin_amdgcn_mfma_f32_16x16x32_bf16(Bt[n][k], At[m][k], acc[ai][bj][m][n], 0, 0, 0); __builtin_amdgcn_s_setprio(0); } while (0)
#define PG8_WAIT_V(n) asm volatile("s_waitcnt vmcnt(" #n ")" ::: "memory")
#define PG8_WAIT_L(n) asm volatile("s_waitcnt lgkmcnt(" #n ")" ::: "memory")
#define PG8_BAR __builtin_amdgcn_s_barrier()
#define PG8_SCHED __builtin_amdgcn_sched_barrier(0)
    Unit cur, nxt; int ui = 0;
    if (!S.next(0, cur)) return;
    f32x4 acc[2][2][4][2];
#pragma unroll
    for (int a = 0; a < 2; ++a)
#pragma unroll
        for (int b = 0; b < 2; ++b)
#pragma unroll
            for (int m = 0; m < 4; ++m)
#pragma unroll
                for (int n = 0; n < 2; ++n) acc[a][b][m][n] = (f32x4){0.f, 0.f, 0.f, 0.f};
    bf16x8 At[4][2], B0[2][2], B1[2][2];
    const char* cA = S.a_base(cur); const char* cB = S.b_base(cur);
    PG8_STAGE(PG8_SB(0, 0), cB, voffB); PG8_STAGE(PG8_SB(0, 1), cB + hB, voffB); PG8_STAGE(PG8_SA(0, 0), cA, voffA); PG8_STAGE(PG8_SA(0, 1), cA + hA, voffA);
    if (wr == 1) PG8_BAR;
    PG8_WAIT_V(2); PG8_BAR;
    PG8_STAGE(PG8_SB(1, 0), cB + kstep, voffB); PG8_STAGE(PG8_SA(1, 0), cA + kstep, voffA); PG8_STAGE(PG8_SB(1, 1), cB + hB + kstep, voffB);
    PG8_WAIT_V(6); PG8_BAR;
    for (;;) {
        const bool has_next = S.next(ui + 1, nxt);
        const char* nA = has_next ? S.a_base(nxt) : cA; const char* nB = has_next ? S.b_base(nxt) : cB;
        for (int t = 0; t < nt; t += 2) {
            const bool last = (t == nt - 2);
            const char* a1 = cA + (size_t)(t + 1) * kstep;
            const char* a2 = last ? nA : cA + (size_t)(t + 2) * kstep; const char* b2 = last ? nB : cB + (size_t)(t + 2) * kstep;
            const char* a3 = a2 + kstep; const char* b3 = b2 + kstep;
            PG8_LDB(B0, 0, 0); PG8_LDB(B1, 0, 1); PG8_SCHED; PG8_LDA(At, 0, 0); PG8_STAGE(PG8_SA(1, 1), a1 + hA, voffA);
            PG8_WAIT_V(8); PG8_WAIT_L(0); PG8_BAR; PG8_MMA(0, 0, At, B0); PG8_MMA(0, 1, At, B1); PG8_BAR; PG8_SCHED;
            PG8_LDA(At, 0, 1); PG8_STAGE(PG8_SB(0, 0), b2, voffB); PG8_STAGE(PG8_SB(0, 1), b2 + hB, voffB); PG8_STAGE(PG8_SA(0, 0), a2, voffA);
            PG8_WAIT_V(8); PG8_WAIT_L(0); PG8_BAR; PG8_MMA(1, 0, At, B0); PG8_MMA(1, 1, At, B1); PG8_BAR; PG8_SCHED;
            PG8_LDB(B0, 1, 0); PG8_LDB(B1, 1, 1); PG8_SCHED; PG8_LDA(At, 1, 0); PG8_STAGE(PG8_SA(0, 1), a2 + hA, voffA);
            PG8_WAIT_V(8); PG8_WAIT_L(0); PG8_BAR; PG8_MMA(0, 0, At, B0); PG8_MMA(0, 1, At, B1); PG8_BAR; PG8_SCHED;
            PG8_LDA(At, 1, 1); PG8_STAGE(PG8_SB(1, 0), b3, voffB); PG8_STAGE(PG8_SB(1, 1), b3 + hB, voffB); PG8_STAGE(PG8_SA(1, 0), a3, voffA);
            PG8_WAIT_V(8); PG8_WAIT_L(0); PG8_BAR; PG8_MMA(1, 0, At, B0); PG8_MMA(1, 1, At, B1); PG8_BAR; PG8_SCHED;
        }
        if (wr == 0) PG8_BAR;
        { int fr2 = fr, fq2 = fq; asm volatile("" : "+v"(fr2), "+v"(fq2));
          E(acc, cur, wr, wc, fr2, fq2, elds); }
        if (!has_next) break;
#pragma unroll
        for (int a = 0; a < 2; ++a)
#pragma unroll
            for (int b = 0; b < 2; ++b)
#pragma unroll
                for (int m = 0; m < 4; ++m)
#pragma unroll
                    for (int n = 0; n < 2; ++n) acc[a][b][m][n] = (f32x4){0.f, 0.f, 0.f, 0.f};
        cur = nxt; cA = nA; cB = nB; ++ui;
        if (wr == 1) PG8_BAR;
    }
    PG8_WAIT_V(0);
    PG8_BAR;
#undef PG8_SA
#undef PG8_SB
#undef PG8_STAGE
#undef PG8_LDA
#undef PG8_LDB
#undef PG8_MMA
#undef PG8_WAIT_V
#undef PG8_WAIT_L
#undef PG8_BAR
#undef PG8_SCHED
}

__device__ __forceinline__ int batch_of_pm(int pm) { return pm < 64 ? 0 : 1 + ((pm - 64) >> 3); }
struct PolSimple {
    const bf16_t* A; const bf16_t* Bt; int nM, nN, lda, ldb, G, c;
    __device__ __forceinline__ bool next(int i, Unit& u) const { const long L = (long)i * G + c; if (L >= (long)nM * nN) return false; map_tile((int)L, nM, nN, u.pm, u.pn); u.gid = 0; return true; }
    __device__ __forceinline__ const char* a_base(const Unit& u) const { return (const char*)(A + (size_t)u.pm * 256 * lda); }
    __device__ __forceinline__ const char* b_base(const Unit& u) const { return (const char*)(Bt + (size_t)u.pn * 256 * ldb); }
};
struct PolP1 {
    const char* ws; int G, c;
    __device__ __forceinline__ bool next(int i, Unit& u) const {
        long L = (long)i * G + c;
        if (L < 1344) { map_tile((int)L, 192, 7, u.pm, u.pn); u.gid = 0; return true; } L -= 1344;
        if (L < 68) { map_tile((int)L, 17, 4, u.pm, u.pn); u.gid = 1; return true; } L -= 68;
        if (L < 68) { map_tile((int)L, 4, 17, u.pm, u.pn); u.gid = 2; return true; }
        return false;
    }
    __device__ __forceinline__ const char* a_base(const Unit& u) const {
        const size_t off = u.gid == 0 ? WS_XN1 : (u.gid == 1 ? WS_MN : WS_WCKV + (size_t)1024 * 1024 * 2); return ws + off + (size_t)u.pm * 256 * 1024 * 2; }
    __device__ __forceinline__ const char* b_base(const Unit& u) const {
        const size_t off = u.gid == 0 ? WS_WIN : (u.gid == 1 ? WS_WCKV : WS_MN); return ws + off + (size_t)u.pn * 256 * 1024 * 2; }
};
struct PolS {
    const bf16_t* QC; const bf16_t* KC; int G, c;
    __device__ __forceinline__ bool next(int i, Unit& u) const { const long L = (long)i * G + c; if (L >= 768) return false; map_tile((int)L, 192, 4, u.pm, u.pn); u.gid = 0; return true; }
    __device__ __forceinline__ const char* a_base(const Unit& u) const { return (const char*)(QC + (size_t)u.pm * 256 * 1024 + u.pn * 256); }
    __device__ __forceinline__ const char* b_base(const Unit& u) const { return (const char*)(KC + (size_t)batch_of_pm(u.pm) * 256 * 1024 + u.pn * 256); }
};
struct PolPV {
    const bf16_t* PC; const bf16_t* VT; int G, c;
    __device__ __forceinline__ bool next(int i, Unit& u) const { const long L = (long)i * G + c; if (L >= 768) return false; map_tile((int)L, 192, 4, u.pm, u.pn); u.gid = 0; return true; }
    __device__ __forceinline__ const char* a_base(const Unit& u) const { return (const char*)(PC + (size_t)u.pm * 256 * 1024 + u.pn * 256); }
    __device__ __forceinline__ const char* b_base(const Unit& u) const { return (const char*)(VT + (size_t)u.pn * 256 * NMEMROWS + batch_of_pm(u.pm) * 256); }
};

typedef f32x4 Acc[2][2][4][2];
__device__ __forceinline__ float dot4(f32x4 x) { return (x[0] * x[0] + x[1] * x[1]) + (x[2] * x[2] + x[3] * x[3]); }
__device__ __forceinline__ float sum4(f32x4 x) { return (x[0] + x[1]) + (x[2] + x[3]); }
__device__ __forceinline__ void st_bf16x8(bf16_t* p, f32x4 v0, f32x4 v1) {
    u32x4 w; w.x = cvt_pk_bf16(v0[0], v0[1]); w.y = cvt_pk_bf16(v0[2], v0[3]); w.z = cvt_pk_bf16(v1[0], v1[1]); w.w = cvt_pk_bf16(v1[2], v1[3]); *(u32x4*)p = w; }
__device__ __forceinline__ void st_bf16x8_q4(bf16_t* p, f32x4 v0, f32x4 v1) {
    u32x4 w; w.x = cvt_pk_bf16(v0[0], v0[1]); w.y = cvt_pk_bf16(v0[2], v0[3]); w.z = cvt_pk_bf16(v1[0], v1[1]); w.w = cvt_pk_bf16(v1[2], v1[3]);
    w = (w + 0x00080008u) & 0xFFF0FFF0u; *(u32x4*)p = w; }
template <bool Q4 = false>
__device__ __forceinline__ void epi_plain(const Acc& acc, int row0, int wr, int wc, int fr, int fq, bf16_t* dst, size_t ldd, int dcol0, int bjs = 128) {
#pragma unroll
    for (int ai = 0; ai < 2; ++ai)
#pragma unroll
        for (int m = 0; m < 4; ++m) { bf16_t* rp = dst + (size_t)(row0 + ai * 128 + wr * 64 + m * 16 + fr) * ldd + dcol0 + wc * 32 + 8 * fq;
#pragma unroll
            for (int bj = 0; bj < 2; ++bj) { if (Q4) st_bf16x8_q4(rp + bj * bjs, acc[ai][bj][m][0], acc[ai][bj][m][1]); else st_bf16x8(rp + bj * bjs, acc[ai][bj][m][0], acc[ai][bj][m][1]); } }
}
template <int MODE>
__device__ __forceinline__ void epi_rowred256(Acc& acc, int row0, int wr, int wc, int fr, int fq, LAS unsigned char* el,
                                              const float* rs, const float* g, float extra, bf16_t* dst, size_t ldd, int dcol0) {
    LAS float* P = (LAS float*)el;
    float red[2][4];
#pragma unroll
    for (int ai = 0; ai < 2; ++ai)
#pragma unroll
        for (int m = 0; m < 4; ++m) {
            float pre = 1.f; if (MODE == 0 && rs) pre = rsqrtf(rs[row0 + ai * 128 + wr * 64 + m * 16 + fr] * (1.f / 1024.f) + EPS);
            float s = 0.f;
#pragma unroll
            for (int bj = 0; bj < 2; ++bj)
#pragma unroll
                for (int n = 0; n < 2; ++n) { f32x4 x = acc[ai][bj][m][n];
                    if (MODE == 0) { x = x * pre; s += dot4(x); } else { x[0] = __expf(x[0]); x[1] = __expf(x[1]); x[2] = __expf(x[2]); x[3] = __expf(x[3]); s += sum4(x); }
                    acc[ai][bj][m][n] = x; }
            s += __shfl_xor(s, 16); s += __shfl_xor(s, 32);
            red[ai][m] = s;
        }
    if (fq == 0) {
#pragma unroll
        for (int ai = 0; ai < 2; ++ai)
#pragma unroll
            for (int m = 0; m < 4; ++m) P[(ai * 128 + wr * 64 + m * 16 + fr) * 4 + wc] = red[ai][m];
    }
    RAW_BAR();
#pragma unroll
    for (int ai = 0; ai < 2; ++ai)
#pragma unroll
        for (int m = 0; m < 4; ++m) { const int rl = ai * 128 + wr * 64 + m * 16 + fr;
            const f32x4 t = *(const LAS f32x4*)&P[rl * 4]; const float tot = (t[0] + t[1]) + (t[2] + t[3]);
            const float sc = MODE == 0 ? rsqrtf(tot * (1.f / 256.f) + EPS) * extra : 1.f / tot;
            bf16_t* rp = dst + (size_t)(row0 + rl) * ldd + dcol0 + wc * 32 + 8 * fq;
#pragma unroll
            for (int bj = 0; bj < 2; ++bj) { f32x4 v0 = acc[ai][bj][m][0] * sc, v1 = acc[ai][bj][m][1] * sc;
                if (MODE == 0) { const float* gp = g + bj * 128 + wc * 32 + 8 * fq; v0 = v0 * *(const f32x4*)gp; v1 = v1 * *(const f32x4*)(gp + 4); }
                st_bf16x8(rp + bj * 128, v0, v1); } }
}

struct EpiP1 {
    bf16_t *PB, *QB, *KB, *VB, *KC, *VT; const float *g_q, *g_k, *g_ck, *rope;
    __device__ __forceinline__ void operator()(Acc& acc, const Unit& u, int wr, int wc, int fr, int fq, LAS unsigned char* el) const {
        const int row0 = u.pm * 256;
        if (u.gid == 1) { epi_rowred256<0>(acc, row0, wr, wc, fr, fq, el, nullptr, g_ck, 0.0625f, KC, 1024, u.pn * 256); return; }
        if (u.gid == 2) { epi_plain(acc, row0, wr, wc, fr, fq, VT, NMEMROWS, u.pn * 256); return; }
        if (u.pn < 2) { epi_plain(acc, row0, wr, wc, fr, fq, PB, 512, u.pn * 256); return; }
        if (u.pn == 6) { epi_plain<true>(acc, row0, wr, wc, fr, fq, KB, 512, 128, 256); return; }
        const bool isk = (u.pn == 5);
        const float* gain = isk ? g_k : g_q; bf16_t* dst = isk ? KB : QB; const size_t ldd = isk ? 512 : 768; const int hcol0 = isk ? 0 : (u.pn - 2) * 256; const int bjs = isk ? 256 : 128;
        LAS float* P = (LAS float*)el;
#pragma unroll
        for (int ai = 0; ai < 2; ++ai)
#pragma unroll
            for (int m = 0; m < 4; ++m)
#pragma unroll
                for (int bj = 0; bj < 2; ++bj) { float s = dot4(acc[ai][bj][m][0]) + dot4(acc[ai][bj][m][1]);
                    s += __shfl_xor(s, 16); s += __shfl_xor(s, 32);
                    if (fq == 0) P[((ai * 128 + wr * 64 + m * 16 + fr) * 2 + bj) * 4 + wc] = s; }
        RAW_BAR();
        const int blk = wc >> 1, j0 = 16 * (wc & 1) + 4 * fq;
        const f32x4 ga = *(const f32x4*)(gain + 64 * blk + j0), gb = *(const f32x4*)(gain + 64 * blk + 32 + j0);
#pragma unroll
        for (int ai = 0; ai < 2; ++ai)
#pragma unroll
            for (int m = 0; m < 4; ++m) { const int rl = ai * 128 + wr * 64 + m * 16 + fr, row = row0 + rl;
                const int pos = row < TP ? row : ((row - TP) & (SS_LEN - 1)); const int v = blk == 0 ? (pos >> 6) : (pos & 63);
                const float* rp = rope + (size_t)(v * 32 + j0) * 2; const f32x4 cs0 = *(const f32x4*)rp, cs1 = *(const f32x4*)(rp + 4);
                const f32x4 cc = (f32x4){cs0[0], cs0[2], cs1[0], cs1[2]}, sn = (f32x4){cs0[1], cs0[3], cs1[1], cs1[3]};
#pragma unroll
                for (int bj = 0; bj < 2; ++bj) { const f32x4 t = *(const LAS f32x4*)&P[(rl * 2 + bj) * 4];
                    const float rstd = rsqrtf(((t[0] + t[1]) + (t[2] + t[3])) * (1.f / 128.f) + EPS);
                    const f32x4 a = acc[ai][bj][m][0] * rstd * ga, b = acc[ai][bj][m][1] * rstd * gb;
                    st_bf16x8_q4(dst + (size_t)row * ldd + hcol0 + bj * bjs + wc * 32 + 8 * fq, a * cc - b * sn, b * cc + a * sn); } }
    }
};
struct EpiResid {
    const float* base0; const float* base1; float* out; bf16_t* xb; float* ss; int row_off;
    __device__ __forceinline__ void operator()(Acc& acc, const Unit& u, int wr, int wc, int fr, int fq, LAS unsigned char* el) const {
#pragma unroll
        for (int ai = 0; ai < 2; ++ai)
#pragma unroll
            for (int m = 0; m < 4; ++m) { const int row = row_off + u.pm * 256 + ai * 128 + wr * 64 + m * 16 + fr;
                const float* bp = row < TP ? base0 + (size_t)row * DM : base1 + (size_t)(row - TP) * DM; float s = 0.f;
#pragma unroll
                for (int bj = 0; bj < 2; ++bj) { const int col = u.pn * 256 + bj * 128 + wc * 32 + 8 * fq;
                    const f32x4 o0 = *(const f32x4*)(bp + col) + acc[ai][bj][m][0], o1 = *(const f32x4*)(bp + col + 4) + acc[ai][bj][m][1];
                    float* op = out + (size_t)row * DM + col; *(f32x4*)op = o0; *(f32x4*)(op + 4) = o1;
                    if (xb) { st_bf16x8(xb + (size_t)row * DM + col, o0, o1); s += dot4(o0) + dot4(o1); } }
                if (ss) { s += __shfl_xor(s, 16); s += __shfl_xor(s, 32); if (fq == 0) atomicAdd(ss + row, s); } }
    }
};
struct EpiCq { const float* ss2; const float* g_cq; bf16_t* QC;
    __device__ __forceinline__ void operator()(Acc& acc, const Unit& u, int wr, int wc, int fr, int fq, LAS unsigned char* el) const {
        epi_rowred256<0>(acc, u.pm * 256, wr, wc, fr, fq, el, ss2, g_cq, 1.f, QC, 1024, u.pn * 256); } };
struct EpiSoftmax { bf16_t* PC;
    __device__ __forceinline__ void operator()(Acc& acc, const Unit& u, int wr, int wc, int fr, int fq, LAS unsigned char* el) const {
        epi_rowred256<1>(acc, u.pm * 256, wr, wc, fr, fq, el, nullptr, nullptr, 1.f, PC, 1024, u.pn * 256); } };
struct EpiPlain { bf16_t* O; size_t ldd;
    __device__ __forceinline__ void operator()(Acc& acc, const Unit& u, int wr, int wc, int fr, int fq, LAS unsigned char* el) const {
        epi_plain(acc, u.pm * 256, wr, wc, fr, fq, O, ldd, u.pn * 256); } };
struct EpiUp { const float* ss3; bf16_t* H; int row_off;
    __device__ __forceinline__ void operator()(Acc& acc, const Unit& u, int wr, int wc, int fr, int fq, LAS unsigned char* el) const {
#pragma unroll
        for (int ai = 0; ai < 2; ++ai)
#pragma unroll
            for (int m = 0; m < 4; ++m) { const int rl = u.pm * 256 + ai * 128 + wr * 64 + m * 16 + fr;
                const float rstd = rsqrtf(ss3[row_off + rl] * (1.f / 1024.f) + EPS);
                bf16_t* rp = H + (size_t)rl * 4096 + u.pn * 256 + wc * 32 + 8 * fq;
#pragma unroll
                for (int bj = 0; bj < 2; ++bj) { f32x4 v0 = acc[ai][bj][m][0] * rstd, v1 = acc[ai][bj][m][1] * rstd;
#pragma unroll
                    for (int i = 0; i < 4; ++i) { const float a = fmaxf(v0[i], 0.f), b = fmaxf(v1[i], 0.f); v0[i] = a * a; v1[i] = b * b; }
                    st_bf16x8(rp + bj * 128, v0, v1); } }
    }
};
}

namespace att {
constexpr int D = 128, NW = 8, QBLK = 32, KVBLK = 64;
constexpr float SCALE = 0.088388347648318440f;
constexpr float THR = 8.f;
constexpr int LDQ = 768, LDK = 512, LDO = 1024;
constexpr size_t SHM_V = KVBLK * D * 2, SHM_K = KVBLK * D * 2, SHM_ATTN = 2 * SHM_V + 2 * SHM_K + NW * 64 * 4;
#define KSWZ(row, colB) ((row) * 256 + ((colB) ^ (((row) & 7) << 4)))
#define SBAR() __builtin_amdgcn_sched_barrier(0)
__device__ __forceinline__ int crow(int r, int hi) { return (r & 3) + 8 * (r >> 2) + 4 * hi; }
__device__ __forceinline__ unsigned cvtpk(float lo, float hi) { unsigned r; asm volatile("v_cvt_pk_bf16_f32 %0, %1, %2" : "=v"(r) : "v"(lo), "v"(hi)); return r; }
template <bool ST>
__device__ __forceinline__ void partialSM(f32x16& p0, f32x16& p1, float& m_reg, float& mn, float& alpha, float negBC) {
  constexpr float C = SCALE * 1.4426950408889634f;
  float mnC;
  if constexpr (ST) { mn = 0.f; alpha = 1.f; mnC = negBC; }
  else {
  float pmax = p0[0]; for (int r = 1; r < 16; ++r) pmax = fmaxf(pmax, p0[r]); for (int r = 0; r < 16; ++r) pmax = fmaxf(pmax, p1[r]);
  { auto rr = __builtin_amdgcn_permlane32_swap(__float_as_uint(pmax), __float_as_uint(pmax), false, false);
    pmax = fmaxf(__uint_as_float(rr[0]), __uint_as_float(rr[1])); }
  if (__builtin_expect(__all(pmax - m_reg <= THR / SCALE), 1)) { mn = m_reg; alpha = 1.f; }
  else { mn = fmaxf(m_reg, pmax); alpha = __builtin_amdgcn_exp2f((m_reg - mn) * C); m_reg = mn; }
  mnC = -mn * C;
  }
  for (int r = 0; r < 16; ++r) p0[r] = fmaf(p0[r], C, mnC); for (int r = 0; r < 16; ++r) p1[r] = fmaf(p1[r], C, mnC);
  for (int r = 0; r < 16; ++r) p0[r] = __builtin_amdgcn_exp2f(p0[r]);
}
__device__ __forceinline__ void finishSM(f32x16& p0, f32x16& p1, float alpha, float& l_reg, bf16x8& pa0, bf16x8& pa1, bf16x8& pa2, bf16x8& pa3) {
  for (int r = 0; r < 16; ++r) p1[r] = __builtin_amdgcn_exp2f(p1[r]);
  float ps = 0; for (int r = 0; r < 16; ++r) ps += p0[r]; for (int r = 0; r < 16; ++r) ps += p1[r];
  { auto rr = __builtin_amdgcn_permlane32_swap(__float_as_uint(ps), __float_as_uint(ps), false, false);
    ps = __uint_as_float(rr[0]) + __uint_as_float(rr[1]); }
  l_reg = l_reg * alpha + ps;
#define PK4(P, BASE, OUT) do { unsigned a0 = cvtpk(P[BASE + 0], P[BASE + 1]), a1 = cvtpk(P[BASE + 2], P[BASE + 3]);   \
    unsigned b0 = cvtpk(P[BASE + 4], P[BASE + 5]), b1 = cvtpk(P[BASE + 6], P[BASE + 7]);                              \
    auto r0 = __builtin_amdgcn_permlane32_swap(a0, b0, false, false); auto r1 = __builtin_amdgcn_permlane32_swap(a1, b1, false, false); \
    u32x4 w = {r0[0], r1[0], r0[1], r1[1]}; OUT = *reinterpret_cast<bf16x8*>(&w); } while (0)
  PK4(p0, 0, pa0); PK4(p0, 8, pa1); PK4(p1, 0, pa2); PK4(p1, 8, pa3);
#undef PK4
}
__device__ __forceinline__ void qkt(f32x16& p0, f32x16& p1, const LAS unsigned char* Ks, const bf16x8* qr, int r32, int hi) {
  p0 = f32x16{}; p1 = f32x16{};
  for (int d0 = 0; d0 < 8; ++d0) { int cb = (d0 * 16 + hi * 8) * 2;
    bf16x8 b0 = *reinterpret_cast<const LAS bf16x8*>(Ks + KSWZ(r32, cb));
    bf16x8 b1 = *reinterpret_cast<const LAS bf16x8*>(Ks + KSWZ(32 + r32, cb));
    p0 = __builtin_amdgcn_mfma_f32_32x32x16_bf16(b0, qr[d0], p0, 0, 0, 0);
    p1 = __builtin_amdgcn_mfma_f32_32x32x16_bf16(b1, qr[d0], p1, 0, 0, 0); }
}
__device__ __forceinline__ int v_st(int k, int c) { const int kk = (k & ~0xC) | ((k & 4) << 1) | ((k & 8) >> 1); return ((kk >> 3) * 4 + (c >> 5)) * 512 + ((kk & 7) * 32 + (c & 31)) * 2; }
__device__ __forceinline__ int v_rd_base(int lane) { return ((lane & 3) << 3) | (((lane >> 2) & 3) << 6) | (((lane >> 4) & 1) << 5) | (((lane >> 5) & 1) << 8); }
constexpr int v_rd_off(int d0, int ks, int half) { return d0 * 512 + ks * 4096 + half * 2048; }
template <int OFF> __device__ __forceinline__ s16x4 tr_read(int vb) {
  s16x4 r; asm volatile("ds_read_b64_tr_b16 %0, %1 offset:%2" : "=&v"(r) : "v"(vb), "i"(OFF) : "memory"); return r;
}
template <int D0> __device__ __forceinline__ void pv_one(f32x16& od, int vb, bf16x8 pa0, bf16x8 pa1, bf16x8 pa2, bf16x8 pa3) {
  const s16x4 l0 = tr_read<v_rd_off(D0, 0, 0)>(vb), h0 = tr_read<v_rd_off(D0, 0, 1)>(vb), l1 = tr_read<v_rd_off(D0, 1, 0)>(vb), h1 = tr_read<v_rd_off(D0, 1, 1)>(vb);
  const s16x4 l2 = tr_read<v_rd_off(D0, 2, 0)>(vb), h2 = tr_read<v_rd_off(D0, 2, 1)>(vb), l3 = tr_read<v_rd_off(D0, 3, 0)>(vb), h3 = tr_read<v_rd_off(D0, 3, 1)>(vb);
  asm volatile("s_waitcnt lgkmcnt(0)" ::: "memory"); SBAR();
#define PK(L, H) (bf16x8){L[0], L[1], L[2], L[3], H[0], H[1], H[2], H[3]}
  od = __builtin_amdgcn_mfma_f32_32x32x16_bf16(pa0, PK(l0, h0), od, 0, 0, 0);
  od = __builtin_amdgcn_mfma_f32_32x32x16_bf16(pa1, PK(l1, h1), od, 0, 0, 0);
  od = __builtin_amdgcn_mfma_f32_32x32x16_bf16(pa2, PK(l2, h2), od, 0, 0, 0);
  od = __builtin_amdgcn_mfma_f32_32x32x16_bf16(pa3, PK(l3, h3), od, 0, 0, 0);
#undef PK
}
__device__ __forceinline__ void pv_d0(f32x16* o, int vb, bf16x8 pa0, bf16x8 pa1, bf16x8 pa2, bf16x8 pa3) {
  pv_one<0>(o[0], vb, pa0, pa1, pa2, pa3); pv_one<1>(o[1], vb, pa0, pa1, pa2, pa3); pv_one<2>(o[2], vb, pa0, pa1, pa2, pa3); pv_one<3>(o[3], vb, pa0, pa1, pa2, pa3);
}
template <bool ST>
__device__ __forceinline__ void attn_dense_body(float negBC, const bf16_t* __restrict__ Qb, const bf16_t* __restrict__ Kh, const bf16_t* __restrict__ Vh,
                                                bf16_t* __restrict__ Ob, int seq, LAS unsigned char* lds, LAS unsigned char* scr, int wave_id) {
  const int tid = opaque_tid(wave_id), wid = wave_id, lane = tid & 63, r32 = lane & 31, hi = lane >> 5;
  LAS float* ws = (LAS float*)scr + wid * 64; LAS float* li_l = ws; LAS float* al_l = ws + 32;
  float m_reg = -1e30f, l_reg = 0; f32x16 o[4] = {}; bf16x8 qr[8];
  const bf16_t* Qw = Qb + (long)(wid * QBLK + r32) * LDQ + hi * 8;
#pragma unroll
  for (int d0 = 0; d0 < 8; ++d0) qr[d0] = *reinterpret_cast<const bf16x8*>(Qw + d0 * 16);
  unsigned offK[2], offV[2];
#pragma unroll
  for (int i = 0; i < 2; ++i) { const int b = (i * 8 + wid) * 1024 + lane * 16;
    { const int row = b >> 8, colB = (b & 255) ^ ((row & 7) << 4); offK[i] = (unsigned)(row * LDK * 2 + colB); }
    { const int sub = b >> 9, within = b & 511, kk = (sub >> 2) * 8 + (within >> 6), k = (kk & ~0xC) | ((kk & 4) << 1) | ((kk & 8) >> 1), c = (sub & 3) * 32 + (within & 63) / 2;
      offV[i] = (unsigned)((k * LDK + c) * 2); } }
  const int vb0 = (int)(uintptr_t)(lds + 16384) + v_rd_base(lane);
#define AISSUE(t) do { const int _sl = (t) & 3; const char* _kp = (const char*)Kh + (size_t)(t) * (KVBLK * LDK * 2); const char* _vp = (const char*)Vh + (size_t)(t) * (KVBLK * LDK * 2); \
    _Pragma("unroll") for (int _i = 0; _i < 2; ++_i) { \
      __builtin_amdgcn_global_load_lds((const unsigned*)(_kp + offK[_i]), (LAS unsigned*)(lds + _sl * 32768 + (_i * 8 + wid) * 1024), 16, 0, 0); \
      __builtin_amdgcn_global_load_lds((const unsigned*)(_vp + offV[_i]), (LAS unsigned*)(lds + _sl * 32768 + 16384 + (_i * 8 + wid) * 1024), 16, 0, 0); } } while (0)
#define KPTR(t) ((const LAS unsigned char*)(lds + ((t) & 3) * 32768))
#define VBASE(t) (vb0 + ((t) & 3) * 32768)
#define WAITV4() asm volatile("s_waitcnt vmcnt(4)" ::: "memory")
#define WAITV0() asm volatile("s_waitcnt vmcnt(0)" ::: "memory")
#define RESC(a) do { if (!ST && __any((a) < 1.f)) { if (hi == 0) al_l[r32] = (a); asm volatile("s_waitcnt lgkmcnt(0)" ::: "memory"); \
    for (int d = 0; d < 4; ++d) for (int r = 0; r < 16; ++r) o[d][r] *= al_l[crow(r, hi)]; } } while (0)
  f32x16 pA0, pA1, pB0, pB1; float mnA, mnB, alA, alB; bf16x8 pa0, pa1, pa2, pa3; const int NT = seq / KVBLK;
  AISSUE(0); AISSUE(1);
  WAITV4(); RAW_BAR();
  AISSUE(2);
  qkt(pA0, pA1, KPTR(0), qr, r32, hi); partialSM<ST>(pA0, pA1, m_reg, mnA, alA, negBC);
  for (int j = 1; j + 1 < NT; j += 2) {
    WAITV4(); RAW_BAR();
    AISSUE(j + 2);
    SBAR(); qkt(pB0, pB1, KPTR(j), qr, r32, hi);
    finishSM(pA0, pA1, alA, l_reg, pa0, pa1, pa2, pa3); SBAR();
    pv_d0(o, VBASE(j - 1), pa0, pa1, pa2, pa3); partialSM<ST>(pB0, pB1, m_reg, mnB, alB, negBC);
    RESC(alB);
    WAITV4(); RAW_BAR();
    if (j + 3 < NT) AISSUE(j + 3);
    SBAR(); qkt(pA0, pA1, KPTR(j + 1), qr, r32, hi);
    finishSM(pB0, pB1, alB, l_reg, pa0, pa1, pa2, pa3); SBAR();
    pv_d0(o, VBASE(j), pa0, pa1, pa2, pa3); partialSM<ST>(pA0, pA1, m_reg, mnA, alA, negBC);
    RESC(alA);
  }
  WAITV0(); RAW_BAR();
  SBAR(); qkt(pB0, pB1, KPTR(NT - 1), qr, r32, hi);
  finishSM(pA0, pA1, alA, l_reg, pa0, pa1, pa2, pa3); SBAR();
  pv_d0(o, VBASE(NT - 2), pa0, pa1, pa2, pa3); partialSM<ST>(pB0, pB1, m_reg, mnB, alB, negBC);
  RESC(alB);
  finishSM(pB0, pB1, alB, l_reg, pa0, pa1, pa2, pa3); SBAR();
  pv_d0(o, VBASE(NT - 1), pa0, pa1, pa2, pa3);
  if (hi == 0) li_l[r32] = l_reg; asm volatile("s_waitcnt lgkmcnt(0)" ::: "memory");
  float rli[16];
#pragma unroll
  for (int r = 0; r < 16; ++r) rli[r] = __builtin_amdgcn_rcpf(li_l[crow(r, hi)]);
  bf16_t* Ow = Ob + (long)(wid * QBLK) * LDO;
#pragma unroll
  for (int r = 0; r < 16; ++r) { int orow = crow(r, hi);
    for (int d0 = 0; d0 < 4; ++d0) Ow[(long)orow * LDO + d0 * 32 + r32] = (bf16_t)f2bf(o[d0][r] * rli[r]); }
#undef AISSUE
#undef KPTR
#undef VBASE
#undef WAITV4
#undef WAITV0
#undef RESC
}

#define KSWZ16(row, colB) ((row) * 256 + ((colB) ^ (((row) & 15) << 4)))
typedef f32x4 S16[4][2];
constexpr int v16_off(int kk, int h, int db) { return kk * 8192 + h * 4096 + db * 256; }
__device__ __forceinline__ void qkt16(S16& s, const LAS unsigned char* Ks, const bf16x8 (&qf)[2][4], const int (&kb_dk)[4]) {
#pragma unroll
  for (int kb = 0; kb < 4; ++kb) { s[kb][0] = (f32x4){0.f, 0.f, 0.f, 0.f}; s[kb][1] = (f32x4){0.f, 0.f, 0.f, 0.f}; }
#pragma unroll
  for (int dk = 0; dk < 4; ++dk)
#pragma unroll
    for (int kb = 0; kb < 4; ++kb) { const bf16x8 kf = *reinterpret_cast<const LAS bf16x8*>(Ks + kb * 4096 + kb_dk[dk]);
      s[kb][0] = __builtin_amdgcn_mfma_f32_16x16x32_bf16(kf, qf[0][dk], s[kb][0], 0, 0, 0);
      s[kb][1] = __builtin_amdgcn_mfma_f32_16x16x32_bf16(kf, qf[1][dk], s[kb][1], 0, 0, 0); }
}
__device__ __forceinline__ void partialSM16(S16& s, float negBC) {
  (void)negBC;
#pragma unroll
  for (int kb = 0; kb < 2; ++kb)
#pragma unroll
    for (int qb = 0; qb < 2; ++qb)
#pragma unroll
      for (int r = 0; r < 4; ++r) s[kb][qb][r] = __builtin_amdgcn_exp2f(s[kb][qb][r]);
}
__device__ __forceinline__ void finishSM16(S16& s, float& l0, float& l1, bf16x8 (&pa)[2][2]) {
#pragma unroll
  for (int kb = 2; kb < 4; ++kb)
#pragma unroll
    for (int qb = 0; qb < 2; ++qb)
#pragma unroll
      for (int r = 0; r < 4; ++r) s[kb][qb][r] = __builtin_amdgcn_exp2f(s[kb][qb][r]);
  f32x4 a0 = (s[0][0] + s[1][0]) + (s[2][0] + s[3][0]), a1 = (s[0][1] + s[1][1]) + (s[2][1] + s[3][1]);
  l0 += (a0[0] + a0[1]) + (a0[2] + a0[3]); l1 += (a1[0] + a1[1]) + (a1[2] + a1[3]);
#pragma unroll
  for (int qb = 0; qb < 2; ++qb)
#pragma unroll
    for (int kk = 0; kk < 2; ++kk) { const f32x4 x = s[2 * kk][qb], y = s[2 * kk + 1][qb];
      u32x4 w = {cvtpk(x[0], x[1]), cvtpk(x[2], x[3]), cvtpk(y[0], y[1]), cvtpk(y[2], y[3])}; pa[qb][kk] = *reinterpret_cast<bf16x8*>(&w); }
}
template <int KK, int DQ> __device__ __forceinline__ void pv16_quad(f32x4 (&o)[2][8], int vb, const bf16x8 (&pa)[2][2]) {
  const s16x4 l0 = tr_read<v16_off(KK, 0, 4 * DQ + 0)>(vb), h0 = tr_read<v16_off(KK, 1, 4 * DQ + 0)>(vb), l1 = tr_read<v16_off(KK, 0, 4 * DQ + 1)>(vb), h1 = tr_read<v16_off(KK, 1, 4 * DQ + 1)>(vb);
  const s16x4 l2 = tr_read<v16_off(KK, 0, 4 * DQ + 2)>(vb), h2 = tr_read<v16_off(KK, 1, 4 * DQ + 2)>(vb), l3 = tr_read<v16_off(KK, 0, 4 * DQ + 3)>(vb), h3 = tr_read<v16_off(KK, 1, 4 * DQ + 3)>(vb);
  asm volatile("s_waitcnt lgkmcnt(0)" ::: "memory"); SBAR();
#define PK(L, H) (bf16x8){L[0], L[1], L[2], L[3], H[0], H[1], H[2], H[3]}
  o[0][4 * DQ + 0] = __builtin_amdgcn_mfma_f32_16x16x32_bf16(pa[0][KK], PK(l0, h0), o[0][4 * DQ + 0], 0, 0, 0);
  o[1][4 * DQ + 0] = __builtin_amdgcn_mfma_f32_16x16x32_bf16(pa[1][KK], PK(l0, h0), o[1][4 * DQ + 0], 0, 0, 0);
  o[0][4 * DQ + 1] = __builtin_amdgcn_mfma_f32_16x16x32_bf16(pa[0][KK], PK(l1, h1), o[0][4 * DQ + 1], 0, 0, 0);
  o[1][4 * DQ + 1] = __builtin_amdgcn_mfma_f32_16x16x32_bf16(pa[1][KK], PK(l1, h1), o[1][4 * DQ + 1], 0, 0, 0);
  o[0][4 * DQ + 2] = __builtin_amdgcn_mfma_f32_16x16x32_bf16(pa[0][KK], PK(l2, h2), o[0][4 * DQ + 2], 0, 0, 0);
  o[1][4 * DQ + 2] = __builtin_amdgcn_mfma_f32_16x16x32_bf16(pa[1][KK], PK(l2, h2), o[1][4 * DQ + 2], 0, 0, 0);
  o[0][4 * DQ + 3] = __builtin_amdgcn_mfma_f32_16x16x32_bf16(pa[0][KK], PK(l3, h3), o[0][4 * DQ + 3], 0, 0, 0);
  o[1][4 * DQ + 3] = __builtin_amdgcn_mfma_f32_16x16x32_bf16(pa[1][KK], PK(l3, h3), o[1][4 * DQ + 3], 0, 0, 0);
#undef PK
}
__device__ __forceinline__ void pv16(f32x4 (&o)[2][8], int vb, const bf16x8 (&pa)[2][2]) {
  pv16_quad<0, 0>(o, vb, pa); pv16_quad<0, 1>(o, vb, pa); pv16_quad<1, 0>(o, vb, pa); pv16_quad<1, 1>(o, vb, pa);
}
__device__ __forceinline__ void attn_body16(float negBC, const bf16_t* __restrict__ Qb, const bf16_t* __restrict__ Kh, const bf16_t* __restrict__ Vh,
                                            bf16_t* __restrict__ Ob, int seq, LAS unsigned char* lds, LAS unsigned char* scr, int wave_id) {
  const int tid = opaque_tid(wave_id), wid = wave_id, lane = tid & 63, c = lane & 15, g = lane >> 4;
  f32x4 o[2][8];
#pragma unroll
  for (int qb = 0; qb < 2; ++qb)
#pragma unroll
    for (int db = 0; db < 8; ++db) o[qb][db] = (f32x4){0.f, 0.f, 0.f, 0.f};
  float l0 = 0.f, l1 = 0.f;
  unsigned offK[2], offV[2];
#pragma unroll
  for (int i = 0; i < 2; ++i) { const int b = (i * 8 + wid) * 1024 + lane * 16;
    { const int row = b >> 8, colB = (b & 255) ^ ((row & 15) << 4); offK[i] = (unsigned)(row * LDK * 2 + colB); }
    { const int sub = b >> 8, within = b & 255, key = (sub >> 3) * 8 + ((within >> 5) & 1) * 4 + (within >> 6), col = (sub & 7) * 16 + (within & 31) / 2;
      offV[i] = (unsigned)((key * LDK + col) * 2); } }
  int kb_dk[4];
#pragma unroll
  for (int dk = 0; dk < 4; ++dk) kb_dk[dk] = c * 256 + (((4 * dk + g) ^ c) << 4);
  const int vb0 = (int)(uintptr_t)(lds + 16384) + (g >> 1) * 2048 + ((lane >> 2) & 3) * 64 + (g & 1) * 32 + (lane & 3) * 8;
#define AISSUE(t) do { const int _sl = (t) & 3; const char* _kp = (const char*)Kh + (size_t)(t) * (KVBLK * LDK * 2); const char* _vp = (const char*)Vh + (size_t)(t) * (KVBLK * LDK * 2); \
    _Pragma("unroll") for (int _i = 0; _i < 2; ++_i) { \
      __builtin_amdgcn_global_load_lds((const unsigned*)(_kp + offK[_i]), (LAS unsigned*)(lds + _sl * 32768 + (_i * 8 + wid) * 1024), 16, 0, 0); \
      __builtin_amdgcn_global_load_lds((const unsigned*)(_vp + offV[_i]), (LAS unsigned*)(lds + _sl * 32768 + 16384 + (_i * 8 + wid) * 1024), 16, 0, 0); } } while (0)
#define KPTR(t) ((const LAS unsigned char*)(lds + ((t) & 3) * 32768))
#define VBASE(t) (vb0 + ((t) & 3) * 32768)
#define WAITV4() asm volatile("s_waitcnt vmcnt(4)" ::: "memory")
#define WAITV0() asm volatile("s_waitcnt vmcnt(0)" ::: "memory")
  S16 sA, sB; bf16x8 pa[2][2]; const int NT = seq / KVBLK;
  AISSUE(0); AISSUE(1);
  bf16x8 qf[2][4];
#pragma unroll
  for (int qb = 0; qb < 2; ++qb)
#pragma unroll
    for (int dk = 0; dk < 4; ++dk) { const u32x4 w = *reinterpret_cast<const u32x4*>(Qb + (long)(wid * 32 + 16 * qb + c) * LDQ + 32 * dk + 8 * g);
      constexpr float C = SCALE * 1.4426950408889634f; u32x4 v;
#pragma unroll
      for (int e = 0; e < 4; ++e) { const float lo = __uint_as_float(w[e] << 16), hi = __uint_as_float(w[e] & 0xffff0000u); v[e] = (cvtpk(lo * C, hi * C) + 0x00080008u) & 0xFFF0FFF0u; }
      qf[qb][dk] = *reinterpret_cast<const bf16x8*>(&v); }
  WAITV0(); RAW_BAR();
  AISSUE(2);
  qkt16(sA, KPTR(0), qf, kb_dk); partialSM16(sA, negBC);
  for (int j = 1; j + 1 < NT; j += 2) {
    WAITV4(); RAW_BAR();
    AISSUE(j + 2);
    SBAR(); qkt16(sB, KPTR(j), qf, kb_dk);
    finishSM16(sA, l0, l1, pa); SBAR();
    pv16(o, VBASE(j - 1), pa); partialSM16(sB, negBC);
    WAITV4(); RAW_BAR();
    if (j + 3 < NT) AISSUE(j + 3);
    SBAR(); qkt16(sA, KPTR(j + 1), qf, kb_dk);
    finishSM16(sB, l0, l1, pa); SBAR();
    pv16(o, VBASE(j), pa); partialSM16(sA, negBC);
  }
  WAITV0(); RAW_BAR();
  SBAR(); qkt16(sB, KPTR(NT - 1), qf, kb_dk);
  finishSM16(sA, l0, l1, pa); SBAR();
  pv16(o, VBASE(NT - 2), pa); partialSM16(sB, negBC);
  finishSM16(sB, l0, l1, pa); SBAR();
  pv16(o, VBASE(NT - 1), pa);
  LAS float* Ls = (LAS float*)scr + wid * 128;
  Ls[(0 * 16 + c) * 4 + g] = l0; Ls[(1 * 16 + c) * 4 + g] = l1;
  asm volatile("s_waitcnt lgkmcnt(0)" ::: "memory");
#pragma unroll
  for (int qb = 0; qb < 2; ++qb)
#pragma unroll
    for (int r = 0; r < 4; ++r) { const f32x4 t = *reinterpret_cast<const LAS f32x4*>(&Ls[(qb * 16 + 4 * g + r) * 4]);
      const float rl = __builtin_amdgcn_rcpf((t[0] + t[1]) + (t[2] + t[3]));
      bf16_t* orow = Ob + (long)(wid * 32 + 16 * qb + 4 * g + r) * LDO + c;
#pragma unroll
      for (int db = 0; db < 8; ++db) orow[16 * db] = (bf16_t)f2bf(o[qb][db][r] * rl); }
  asm volatile("s_waitcnt lgkmcnt(0)" ::: "memory");
#undef AISSUE
#undef KPTR
#undef VBASE
#undef WAITV4
#undef WAITV0
}

__device__ __forceinline__ void dft_task(const bf16_t* __restrict__ src, long row0, int rstride, int NTlog, const bf16_t* __restrict__ F, int frow0, int ch,
                                         LAS unsigned char* vl, int lane, f32x16 (&o)[4]) {
  const int r32 = lane & 31, hi = lane >> 5, NT = 1 << NTlog, K = 2 * NT, ntile = K / 64;
  const int vb = (int)(uintptr_t)vl + v_rd_base(lane);
  const int cc = (lane & 15) * 8, key0 = lane >> 4;
#pragma unroll
  for (int d = 0; d < 4; ++d) o[d] = f32x16{};
  u32x4 st[16];
#define DFT_LOAD1(dst, kt_, i) do { const int kg = (kt_) * 64 + 4 * (i) + key0, ri = kg >> NTlog, tt = kg & (NT - 1); \
      dst = *(const u32x4*)(src + (size_t)(row0 + (long)tt * rstride) * 512 + ri * 256 + ch * 128 + cc); } while (0)
#pragma unroll
  for (int i = 0; i < 16; ++i) DFT_LOAD1(st[i], 0, i);
  for (int kt = 0; kt < ntile; ++kt) {
    constexpr int NPF = 6;
    u32x4 na[NPF];
    const bool more = kt + 1 < ntile;
    if (more) {
#pragma unroll
      for (int i = 0; i < NPF; ++i) DFT_LOAD1(na[i], kt + 1, i);
    }
    const bf16_t* Fp = F + (size_t)(frow0 + r32) * K + kt * 64 + 8 * hi;
    const bf16x8 pa0 = *(const bf16x8*)(Fp), pa1 = *(const bf16x8*)(Fp + 16), pa2 = *(const bf16x8*)(Fp + 32), pa3 = *(const bf16x8*)(Fp + 48);
#pragma unroll
    for (int i = 0; i < 16; ++i) *(LAS u32x4*)(vl + v_st(4 * i + key0, cc)) = st[i];
    asm volatile("s_waitcnt lgkmcnt(0)" ::: "memory");
    pv_d0(o, vb, pa0, pa1, pa2, pa3);
    if (more) {
#pragma unroll
      for (int i = 0; i < NPF; ++i) st[i] = na[i];
#pragma unroll
      for (int i = NPF; i < 16; ++i) DFT_LOAD1(st[i], kt + 1, i);
    }
  }
#undef DFT_LOAD1
}
}


#define XB_TMO      128
#define XB_XCNT(j)  (256  + 64 * (j))
#define XB_XSUB(j)  (1280 + 64 * (j))
#define XB_XGEN(j)  (2304 + 64 * (j))
#define XB_TOP      3328
#define XB_TOPGEN   3392
#define XCD_BAR_WORDS 3456
#define XB_SPIN_CAP (1u << 22)
__device__ __forceinline__ unsigned xb_ld(unsigned* p)              { return __hip_atomic_load(p, __ATOMIC_RELAXED, __HIP_MEMORY_SCOPE_AGENT); }
__device__ __forceinline__ unsigned xb_add(unsigned* p, unsigned v) { return __hip_atomic_fetch_add(p, v, __ATOMIC_RELAXED, __HIP_MEMORY_SCOPE_AGENT); }
__device__ __forceinline__ unsigned xb_xcc_id() { return (unsigned)__builtin_amdgcn_s_getreg((3 << 11) | 20) & 0xFu; }
#define XB_SPIN(cond, bar) do { unsigned _sp = 0; while (cond) { __builtin_amdgcn_s_sleep(1); \
    if ((++_sp & 255u) == 0u) { if (xb_ld(&(bar)[XB_TMO])) break; if (_sp > XB_SPIN_CAP) { atomicAdd(&(bar)[XB_TMO], 1u); break; } } } } while (0)
struct XcdBarrier { unsigned* bar; unsigned x; volatile LAS unsigned* st; };
__device__ __forceinline__ XcdBarrier xcd_barrier_post(unsigned* bar, volatile LAS unsigned* st) {
    XcdBarrier b; b.bar = bar; b.x = xb_xcc_id(); b.st = st;
    if (threadIdx.x == 0) (void)xb_add(&bar[XB_XCNT(b.x)], 1u);
    return b;
}
__device__ __forceinline__ void xcd_barrier_complete(unsigned* bar, unsigned x, unsigned& nloc, unsigned& nx) {
    const unsigned G = gridDim.x * gridDim.y * gridDim.z;
    unsigned sum, cnt, mine, sp = 0u;
    for (;;) {
        sum = 0u; cnt = 0u; mine = 0u;
#pragma unroll
        for (unsigned j = 0; j < 16; ++j) { const unsigned c = xb_ld(&bar[XB_XCNT(j)]); sum += c; cnt += (c > 0u) ? 1u : 0u; mine = (j == x) ? c : mine; }
        if (sum == G) break;
        __builtin_amdgcn_s_sleep(1);
        if ((++sp & 255u) == 0u) { if (xb_ld(&bar[XB_TMO])) break; if (sp > XB_SPIN_CAP) { atomicAdd(&bar[XB_TMO], 1u); break; } }
    }
    nloc = mine > 0u ? mine : 1u; nx = cnt > 0u ? cnt : 1u;
}
__device__ __forceinline__ void xcd_barrier(const XcdBarrier& b) {
    asm volatile("s_waitcnt vmcnt(0)" ::: "memory");
    __syncthreads();
    if (threadIdx.x == 0) {
        unsigned* bar = b.bar;
        __builtin_amdgcn_s_waitcnt(0);
        unsigned nloc = b.st[0], nx = b.st[1];
        if (nloc == 0u) { xcd_barrier_complete(bar, b.x, nloc, nx); b.st[0] = nloc; b.st[1] = nx; }
        const unsigned old = xb_add(&bar[XB_XSUB(b.x)], 1u);
        const unsigned gen = old / nloc;
        if (old + 1u == (gen + 1u) * nloc) {
            __builtin_amdgcn_fence(__ATOMIC_RELEASE, "agent");
            asm volatile("s_waitcnt vmcnt(0)" ::: "memory");
            const unsigned og = xb_add(&bar[XB_TOP], 1u);
            const unsigned tg = og / nx;
            if (og + 1u == (tg + 1u) * nx) xb_add(&bar[XB_TOPGEN], 1u);
            else XB_SPIN(xb_ld(&bar[XB_TOPGEN]) == tg, bar);
            __builtin_amdgcn_fence(__ATOMIC_ACQUIRE, "agent");
            xb_add(&bar[XB_XGEN(b.x)], 1u);
            asm volatile("s_waitcnt vmcnt(0)" ::: "memory");
        } else {
            XB_SPIN(xb_ld(&bar[XB_XGEN(b.x)]) == gen, bar);
            __builtin_amdgcn_fence(__ATOMIC_ACQUIRE, "agent");
            asm volatile("s_waitcnt vmcnt(0)" ::: "memory");
        }
    }
    __syncthreads();
}
__device__ __forceinline__ int perm_headdim(int e) { return 32 * (2 * (e >> 6) + ((e & 31) >> 4)) + 8 * (((e & 31) >> 2) & 3) + 4 * ((e >> 5) & 1) + (e & 3); }
template <int MAP>
__device__ __forceinline__ void tr_item(const float* __restrict__ W, int ldw, int ncols, int K, const float* __restrict__ gk, bf16_t* WT, LAS float* scr, int item, int lane) {
    const int nblk = ncols / 32, kb = item / nblk, nb = item % nblk, k0 = 64 * kb, n0 = 32 * nb;
    float tv[32];
#pragma unroll
    for (int i = 0; i < 32; ++i) { const int kk = 2 * i + (lane >> 5); tv[i] = W[(size_t)(k0 + kk) * ldw + n0 + (lane & 31)]; }
#pragma unroll
    for (int i = 0; i < 32; ++i) { const int kk = 2 * i + (lane >> 5); float v = tv[i]; if (gk) v *= gk[k0 + kk]; scr[kk * 33 + (lane & 31)] = v; }
    LDS_WAIT(); asm volatile("" ::: "memory");
    const int c = lane & 7;
#pragma unroll
    for (int j = 0; j < 4; ++j) { const int n = (lane >> 3) + 8 * j; const LAS float* s = scr + (8 * c) * 33 + n;
        u32x4 o; o.x = pk2(s[0 * 33], s[1 * 33]); o.y = pk2(s[2 * 33], s[3 * 33]); o.z = pk2(s[4 * 33], s[5 * 33]); o.w = pk2(s[6 * 33], s[7 * 33]);
        int dn = n0 + n;
        if (MAP == 1) { dn = dn < 1024 ? 512 + (dn & ~127) + perm_headdim(dn & 127) : 512 + dn; }
        *(u32x4*)(WT + (size_t)dn * K + k0 + 8 * c) = o; }
    LDS_WAIT(); asm volatile("" ::: "memory");
}
template <int NR>
__device__ __forceinline__ void rms_rows_to_bf16(const float* const (&xrow)[NR], const float* __restrict__ g, bf16_t* const (&orow)[NR], int lane) {
    const f32x4* gr = (const f32x4*)g + lane;
    f32x4 v[NR][4];
#pragma unroll
    for (int r = 0; r < NR; ++r)
#pragma unroll
        for (int j = 0; j < 4; ++j) v[r][j] = ((const f32x4*)xrow[r] + lane)[64 * j];
#pragma unroll
    for (int r = 0; r < NR; ++r) { float s = 0.f;
#pragma unroll
        for (int j = 0; j < 4; ++j) s += pg8::dot4(v[r][j]);
        const float rstd = rsqrtf(wave_sum(s) * (1.f / DM) + EPS);
        unsigned long long* o8 = (unsigned long long*)orow[r] + lane;
#pragma unroll
        for (int j = 0; j < 4; ++j) { const f32x4 gg = gr[64 * j]; const f32x4 y = v[r][j] * rstd * gg;
            o8[64 * j] = (unsigned long long)pk2(y[0], y[1]) | ((unsigned long long)pk2(y[2], y[3]) << 32); } }
}
__device__ __forceinline__ float f1_val(int rg, int k, int N1) {
    const int w = rg >> 5, rho = rg & 31, j = rho & 3, hi = (rho >> 2) & 1, q = rho >> 3, ri = q & 1, s1 = 16 * w + 8 * (q >> 1) + 4 * hi + j;
    const int rip = k / N1, t1 = k % N1, m = (s1 * t1) % N1; const float a = 2.f * (float)m / (float)N1; const float c = cospif(a), s = sinpif(a);
    return ri == 0 ? (rip == 0 ? c : s) : (rip == 0 ? -s : c);
}
__device__ __forceinline__ float f2_val(int s2, int k, int N2, float inv) {
    const int ri = k / N2, t2 = k % N2, m = (s2 * t2) % N2; const float a = 2.f * (float)m / (float)N2; return (ri == 0 ? cospif(a) : sinpif(a)) * inv;
}

struct Params { const float* in[20]; float* out; unsigned char* ws; };

__global__ void __launch_bounds__(512, 2) mega_fwd(Params p) {
    extern __shared__ __attribute__((aligned(16))) unsigned char lds_raw[];
    cg::grid_group grid = cg::this_grid();
    LAS unsigned char* lds = (LAS unsigned char*)lds_raw;
    LAS unsigned char* elds = lds + ELDS_OFF;
    const int tid = threadIdx.x, lane = tid & 63, wave = __builtin_amdgcn_readfirstlane(tid >> 6);
    const int G = gridDim.x, cb = blockIdx.x, gw = cb * 8 + wave, NGW = G * 8;
    unsigned char* ws = p.ws;
    const float *x_p = p.in[0], *x_s = p.in[1], *mem_p = p.in[2], *mem_s = p.in[3], *g_mix = p.in[4], *w_in = p.in[5], *w_f = p.in[6], *g_q = p.in[7], *g_k = p.in[8],
                *w_out = p.in[9], *g_cross = p.in[10], *g_mem = p.in[11], *w_cq = p.in[12], *w_ckv = p.in[13], *g_cq = p.in[14], *g_ck = p.in[15], *w_co = p.in[16],
                *g_mlp = p.in[17], *w_up = p.in[18], *w_down = p.in[19];
    float* out = p.out;
    if (tid < 8) ((LAS unsigned*)(lds + MISC_OFF))[tid] = 0u;
    __syncthreads();
    const XcdBarrier xbar = xcd_barrier_post((unsigned*)(ws + WS_BAR), (volatile LAS unsigned*)(lds + MISC_OFF));
#define GRID_BAR() xcd_barrier(xbar)
#define WSP(T, off) ((T*)(ws_launder(ws) + (off)))
#define SS2 WSP(float, WS_SS2)
#define SS3 WSP(float, WS_SS3)
#define ROPE WSP(float, WS_ROPE)
#define F1P WSP(bf16_t, WS_F1P)
#define F2P WSP(bf16_t, WS_F2P)
#define F1S WSP(bf16_t, WS_F1S)
#define F2S WSP(bf16_t, WS_F2S)
#define WIN WSP(bf16_t, WS_WIN)
#define WOUT WSP(bf16_t, WS_WOUT)
#define WCQ WSP(bf16_t, WS_WCQ)
#define WCKV WSP(bf16_t, WS_WCKV)
#define WCO WSP(bf16_t, WS_WCO)
#define WUP WSP(bf16_t, WS_WUP)
#define WDN WSP(bf16_t, WS_WDN)
#define MN WSP(bf16_t, WS_MN)
#define KC WSP(bf16_t, WS_KC)
#define VT WSP(bf16_t, WS_VT)
#define XN1 WSP(bf16_t, WS_XN1)
#define PB WSP(bf16_t, WS_PB)
#define TMP WSP(bf16_t, WS_TMP)
#define QB WSP(bf16_t, WS_QB)
#define KB WSP(bf16_t, WS_KB)
#define VB WSP(bf16_t, WS_VB)
#define MIX WSP(bf16_t, WS_MIX)
#define XB2 WSP(bf16_t, WS_XB2)
#define QC WSP(bf16_t, WS_QC)
#define PC WSP(bf16_t, WS_PC)
#define OC WSP(bf16_t, WS_OC)
#define XB3 WSP(bf16_t, WS_XB3)
#define HB WSP(bf16_t, WS_H)


    {
        if (cb < 32) {
            const int g = cb >> 3, ri = (cb >> 2) & 1, kq = cb & 3;
            LAS float* Wf_s = (LAS float*)lds; LAS float* M_s = (LAS float*)(lds + 16384); LAS float* T_s = (LAS float*)(lds + 16384 + 64 * 68 * 4);
            for (int i = tid; i < 4096; i += 512) Wf_s[i] = w_f[g * 4096 + i];
            if (tid < 64) { const float a = (float)tid / 32.f; T_s[tid] = ri == 0 ? cospif(a) * 0.125f : -sinpif(a) * 0.125f; }
            __syncthreads();
            { const int cp = tid >> 3, d0 = (tid & 7) * 8; float accm[8];
#pragma unroll
              for (int d = 0; d < 8; ++d) accm[d] = 0.f;
              for (int c = 0; c < 64; ++c) { const float t = T_s[(c * cp) & 63];
#pragma unroll
                  for (int d = 0; d < 8; ++d) accm[d] += t * Wf_s[c * 64 + d0 + d]; }
#pragma unroll
              for (int d = 0; d < 8; ++d) M_s[cp * 68 + d0 + d] = accm[d]; }
            __syncthreads();
            { const int k = kq * 256 + wave * 32 + (lane & 31), dh = lane >> 5; float wrow[64];
              const f32x4* wp = (const f32x4*)(w_in + (size_t)k * 1536 + g * 64);
#pragma unroll
              for (int i = 0; i < 16; ++i) { const f32x4 t = wp[i]; wrow[4 * i] = t[0]; wrow[4 * i + 1] = t[1]; wrow[4 * i + 2] = t[2]; wrow[4 * i + 3] = t[3]; }
              float fa[32];
#pragma unroll
              for (int d = 0; d < 32; ++d) fa[d] = 0.f;
#pragma unroll
              for (int c = 0; c < 64; ++c) { const LAS f32x4* mp = (const LAS f32x4*)(M_s + c * 68 + 32 * dh);
#pragma unroll
                  for (int d4 = 0; d4 < 8; ++d4) { const f32x4 m = mp[d4];
                      fa[4 * d4] += wrow[c] * m[0]; fa[4 * d4 + 1] += wrow[c] * m[1]; fa[4 * d4 + 2] += wrow[c] * m[2]; fa[4 * d4 + 3] += wrow[c] * m[3]; } }
#pragma unroll
              for (int d = 0; d < 32; ++d) WIN[(size_t)(ri * 256 + g * 64 + 32 * dh + d) * 1024 + k] = (bf16_t)f2bf(fa[d]); }
        }
        __syncthreads();
        LAS float* scr = (LAS float*)(lds + wave * 16384);
        constexpr int I_IN = 40 * 16, I_SQ = 32 * 16, I_CKV = 64 * 16, I_UP = 128 * 16, I_DN = 32 * 64;
        constexpr int NNOW = I_IN + I_CKV, NLATER = 3 * I_SQ + I_UP + I_DN;
        for (int it = gw; it < NNOW + (G == 256 ? 0 : NLATER); it += NGW) {
            int r = it;
            if (r < I_IN) { tr_item<1>(w_in + 256, 1536, 1280, 1024, nullptr, WIN, scr, r, lane); continue; } r -= I_IN;
            if (r < I_CKV) { tr_item<0>(w_ckv, 2048, 2048, 1024, nullptr, WCKV, scr, r, lane); continue; } r -= I_CKV;
            if (r < I_SQ) { tr_item<0>(w_out, 1024, 1024, 1024, nullptr, WOUT, scr, r, lane); continue; } r -= I_SQ;
            if (r < I_SQ) { tr_item<0>(w_cq, 1024, 1024, 1024, g_cross, WCQ, scr, r, lane); continue; } r -= I_SQ;
            if (r < I_SQ) { tr_item<0>(w_co, 1024, 1024, 1024, nullptr, WCO, scr, r, lane); continue; } r -= I_SQ;
            if (r < I_UP) { tr_item<0>(w_up, 4096, 4096, 1024, g_mlp, WUP, scr, r, lane); continue; } r -= I_UP;
            tr_item<0>(w_down, 1024, 1024, 4096, nullptr, WDN, scr, r, lane);
        }
        for (int m = gw; m < TT; m += 8 * NGW) {
            if (m + 7 * NGW < TT) {
                const float* xr[8]; bf16_t* orw[8];
#pragma unroll
                for (int r = 0; r < 8; ++r) { const int mr = m + r * NGW; xr[r] = mr < TP ? x_p + (size_t)mr * DM : x_s + (size_t)(mr - TP) * DM; orw[r] = XN1 + (size_t)mr * DM; }
                rms_rows_to_bf16<8>(xr, g_mix, orw, lane);
            } else {
                for (int mr = m; mr < TT; mr += NGW) { const float* xr[1] = {mr < TP ? x_p + (size_t)mr * DM : x_s + (size_t)(mr - TP) * DM}; bf16_t* orw[1] = {XN1 + (size_t)mr * DM};
                    rms_rows_to_bf16<1>(xr, g_mix, orw, lane); }
            }
        }
        for (int mm = gw; mm < NMEMROWS; mm += NGW) { const float* xr[1] = {mm < 256 ? mem_p + (size_t)mm * DM : mem_s + (size_t)(mm - 256) * DM}; bf16_t* orw[1] = {MN + (size_t)mm * DM};
            rms_rows_to_bf16<1>(xr, g_mem, orw, lane); }
        for (int i = cb * 512 + tid; i < 118784 + 98304; i += G * 512) {
            int r = i;
            if (r < 65536) { F1P[r] = (bf16_t)f2bf(f1_val(r >> 8, r & 255, 128)); continue; } r -= 65536;
            if (r < 32768) { F2P[r] = (bf16_t)f2bf(f2_val(r >> 8, r & 255, 128, 0.0078125f)); continue; } r -= 32768;
            if (r < 4096) { F1S[r] = (bf16_t)f2bf(f1_val(r >> 6, r & 63, 32)); continue; } r -= 4096;
            if (r < 8192) { F2S[r] = (bf16_t)f2bf(f2_val(r >> 7, r & 127, 64, 0.022097086912079608f)); continue; } r -= 8192;
            if (r < 8192) { const int v = r >> 5, j = r & 31; const float inv = 1.0f / powf(10000.f, (float)(2 * j) / 64.f); const float ang = (float)v * inv;
                ROPE[2 * r] = cosf(ang); ROPE[2 * r + 1] = sinf(ang); continue; } r -= 8192;
            SS2[r] = 0.f;
        }
    }
    grid.sync();

    {
        pg8::PolP1 S{(const char*)ws, G, cb};
        pg8::EpiP1 E{PB, QB, KB, VB, KC, VT, g_q, g_k, g_ck, ROPE};
        pg8::gemm_phase(wave, lds, elds, S, E, 1024, 1024, 1024);
    }
    if (G == 256 && cb >= 200) {
        const int tl = opaque_tid(wave), lane = tl & 63; LAS float* scr = (LAS float*)(lds + wave * 16384);
        constexpr int I_SQ = 32 * 16, I_UP = 128 * 16, I_DN = 32 * 64;
        for (int it = (cb - 200) * 8 + wave; it < 3 * I_SQ + I_UP + I_DN; it += 56 * 8) {
            int r = it;
            if (r < I_SQ) { tr_item<0>(w_out, 1024, 1024, 1024, nullptr, WOUT, scr, r, lane); continue; } r -= I_SQ;
            if (r < I_SQ) { tr_item<0>(w_cq, 1024, 1024, 1024, g_cross, WCQ, scr, r, lane); continue; } r -= I_SQ;
            if (r < I_SQ) { tr_item<0>(w_co, 1024, 1024, 1024, nullptr, WCO, scr, r, lane); continue; } r -= I_SQ;
            if (r < I_UP) { tr_item<0>(w_up, 4096, 4096, 1024, g_mlp, WUP, scr, r, lane); continue; } r -= I_UP;
            tr_item<0>(w_down, 1024, 1024, 4096, nullptr, WDN, scr, r, lane);
        }
    }
    GRID_BAR();

    {
        const int tl = opaque_tid(wave), lane = tl & 63;
        LAS unsigned char* vl = lds + wave * 16384;
        const int r32 = lane & 31, hi = lane >> 5;
        for (int tau = gw; tau < 2048 + 4096; tau += NGW) {
            int ch, w, t2, N2, Slog; long base; const bf16_t* F; int NTlog;
            if (tau < 2048) { ch = tau & 1; w = (tau >> 1) & 7; t2 = tau >> 4; base = 0; N2 = 128; Slog = 14; F = F1P; NTlog = 7; }
            else { const int t = tau - 2048; ch = t & 1; w = (t >> 1) & 1; t2 = (t >> 2) & 63; base = TP + (long)(t >> 8) * SS_LEN; N2 = 64; Slog = 11; F = F1S; NTlog = 5; }
            f32x16 o[4];
            att::dft_task(PB, base + t2, N2, NTlog, F, 32 * w, ch, vl, lane, o);
#pragma unroll
            for (int pp = 0; pp < 2; ++pp)
#pragma unroll
                for (int j = 0; j < 4; ++j) { const int s1 = 16 * w + 8 * pp + 4 * hi + j; const int mm = (s1 * t2) & ((1 << Slog) - 1);
                    const float a = 2.f * (float)mm / (float)(1 << Slog); const float c = cospif(a), s = sinpif(a);
                    bf16_t* dp = TMP + (size_t)(base + (long)s1 * N2 + t2) * 512 + ch * 128 + r32;
#pragma unroll
                    for (int d0 = 0; d0 < 4; ++d0) { const float re = o[d0][8 * pp + j], im = o[d0][8 * pp + 4 + j];
                        dp[d0 * 32] = (bf16_t)f2bf(re * c + im * s); dp[256 + d0 * 32] = (bf16_t)f2bf(im * c - re * s); } }
        }
    }
    GRID_BAR();

    {
        const int tl = opaque_tid(wave), lane = tl & 63;
        LAS unsigned char* vl = lds + wave * 16384;
        const int r32 = lane & 31, hi = lane >> 5;
        for (int it = 0; ; ++it) {
            int tau;
            if (NGW == 2048) { if (gw < 1024) { if (it > 0) break; tau = gw; } else { if (it > 1) break; tau = gw + it * 1024; } }
            else { tau = gw + it * NGW; if (tau >= 1024 + 2048) break; }
            int ch, rb, s1, N1, N2; long base; const bf16_t* F; int NTlog;
            if (tau < 1024) { ch = tau & 1; rb = (tau >> 1) & 3; s1 = tau >> 3; base = 0; N1 = 128; N2 = 128; F = F2P; NTlog = 7; }
            else { const int t = tau - 1024; ch = t & 1; rb = (t >> 1) & 1; s1 = (t >> 2) & 31; base = TP + (long)(t >> 7) * SS_LEN; N1 = 32; N2 = 64; F = F2S; NTlog = 6; }
            f32x16 o[4];
            att::dft_task(TMP, base + (long)s1 * N2, 1, NTlog, F, 32 * rb, ch, vl, lane, o);
#pragma unroll
            for (int r = 0; r < 16; ++r) { const int s2 = 32 * rb + att::crow(r, hi); bf16_t* dp = MIX + (size_t)(base + s1 + (long)N1 * s2) * 1024 + ch * 128 + r32;
#pragma unroll
                for (int d0 = 0; d0 < 4; ++d0) dp[d0 * 32] = (bf16_t)f2bf(o[d0][r]); }
        }
        __syncthreads();
        float gqm = fmaxf(fabsf(g_q[lane]), fabsf(g_q[lane + 64])), gkm = fmaxf(fabsf(g_k[lane]), fabsf(g_k[lane + 64]));
#pragma unroll
        for (int o = 1; o < 64; o <<= 1) { gqm = fmaxf(gqm, __shfl_xor(gqm, o)); gkm = fmaxf(gkm, __shfl_xor(gkm, o)); }
        const float BC = 128.f * 1.02f * gqm * gkm * (att::SCALE * 1.4426950408889634f);
        const bool use_static = BC < 60.f;
        const float negBC = -BC;
        const int nun = (G == 256) ? (cb < 128 ? 2 : 7) : (1152 - cb + G - 1) / G;
        for (int iu = 0; iu < nun; ++iu) {
            int uidx;
            if (G == 256) { const int cc = cb - 128, xk = cc >> 3; uidx = cb < 128 ? cb + 256 * iu : (iu == 0 ? cb : 384 + (2 * (cc & 7) + (xk >> 3)) * 48 + (xk & 7) * 6 + (iu - 1)); }
            else uidx = cb + iu * G;
            long rowbase, kvbase; int h, qb, seq;
            if (uidx < 384) { h = uidx >> 6; qb = uidx & 63; rowbase = 0; kvbase = 0; seq = TP; }
            else { const int v = uidx - 384; const int b = v / 48, rem = v % 48; h = rem >> 3; qb = rem & 7; kvbase = TP + (long)b * SS_LEN; rowbase = kvbase; seq = SS_LEN; }
            const long qrow = rowbase + (long)qb * 256; const int kvh = h / 3;
            if (use_static) att::attn_body16(negBC, QB + (size_t)qrow * 768 + h * 128, KB + (size_t)kvbase * 512 + kvh * 256, KB + (size_t)kvbase * 512 + kvh * 256 + 128,
                                 MIX + (size_t)qrow * 1024 + 256 + h * 128, seq, lds, elds, wave);
            else att::attn_dense_body<false>(0.f, QB + (size_t)qrow * 768 + h * 128, KB + (size_t)kvbase * 512 + kvh * 256, KB + (size_t)kvbase * 512 + kvh * 256 + 128,
                                 MIX + (size_t)qrow * 1024 + 256 + h * 128, seq, lds, elds, wave);
            __syncthreads();
        }
    }
    GRID_BAR();

    {
        pg8::PolSimple S{MIX, WOUT, 192, 4, 1024, 1024, G, cb};
        pg8::EpiResid E{x_p, x_s, out, XB2, SS2, 0};
        pg8::gemm_phase(wave, lds, elds, S, E, 1024, 1024, 1024);
    }
    GRID_BAR();
    {
        pg8::PolSimple S{XB2, WCQ, 192, 4, 1024, 1024, G, cb};
        pg8::EpiCq E{SS2, g_cq, QC};
        pg8::gemm_phase(wave, lds, elds, S, E, 1024, 1024, 1024);
    }
    __syncthreads();
    {
        pg8::PolS S{QC, KC, G, cb};
        pg8::EpiSoftmax E{PC};
        pg8::gemm_phase(wave, lds, elds, S, E, 256, 1024, 1024);
    }
    __syncthreads();
    {
        pg8::PolPV S{PC, VT, G, cb};
        pg8::EpiPlain E{OC, 1024};
        pg8::gemm_phase(wave, lds, elds, S, E, 256, 1024, NMEMROWS);
    }
    GRID_BAR();
    {
        pg8::PolSimple S{OC, WCO, 192, 4, 1024, 1024, G, cb};
        pg8::EpiResid E{out, out + (size_t)TP * DM, out, XB3, SS3, 0};
        pg8::gemm_phase(wave, lds, elds, S, E, 1024, 1024, 1024);
    }
    GRID_BAR();
    for (int ck = 0; ck <= 3; ++ck) {
        if (ck >= 1) {
            pg8::PolSimple S{HB + (size_t)((ck - 1) & 1) * 16384 * 4096, WDN, 64, 4, 4096, 4096, G, cb};
            pg8::EpiResid E{out, out + (size_t)TP * DM, out, nullptr, nullptr, (ck - 1) * 16384};
            pg8::gemm_phase(wave, lds, elds, S, E, 4096, 4096, 4096);
        }
        if (ck < 3) {
            pg8::PolSimple S{XB3 + (size_t)ck * 16384 * DM, WUP, 64, 16, 1024, 1024, G, cb};
            pg8::EpiUp E{SS3, HB + (size_t)(ck & 1) * 16384 * 4096, ck * 16384};
            pg8::gemm_phase(wave, lds, elds, S, E, 1024, 1024, 1024);
            GRID_BAR();
        }
    }
}

#undef WSP
#undef SS2
#undef SS3
#undef ROPE
#undef F1P
#undef F2P
#undef F1S
#undef F2S
#undef WIN
#undef WOUT
#undef WCQ
#undef WCKV
#undef WCO
#undef WUP
#undef WDN
#undef MN
#undef KC
#undef VT
#undef XN1
#undef PB
#undef TMP
#undef QB
#undef KB
#undef VB
#undef MIX
#undef XB2
#undef QC
#undef PC
#undef OC
#undef XB3
#undef HB
extern "C" void kernel_launch(void* const* d_in, const int* in_sizes, int n_in, void* d_out, int out_size, void* d_ws, size_t ws_size, hipStream_t stream) {
    static int grid = 0;
    if (grid == 0) {
        if (n_in != 20 || out_size != TT * DM || ws_size < WS_NEED) { fprintf(stderr, "kernel_launch: unexpected shapes: n_in %d out %d ws %zu\n", n_in, out_size, ws_size); grid = -1; return; }
        int dev = 0, cus = 0, per_cu = 0;
        hipGetDevice(&dev); hipDeviceGetAttribute(&cus, hipDeviceAttributeMultiprocessorCount, dev);
        if (hipFuncSetAttribute((const void*)mega_fwd, hipFuncAttributeMaxDynamicSharedMemorySize, LDS_BYTES) != hipSuccess) { fprintf(stderr, "kernel_launch: hipFuncSetAttribute failed\n"); grid = -1; return; }
        if (hipOccupancyMaxActiveBlocksPerMultiprocessor(&per_cu, (const void*)mega_fwd, 512, LDS_BYTES) != hipSuccess || per_cu < 1) { fprintf(stderr, "kernel_launch: occupancy query failed (%d)\n", per_cu); grid = -1; return; }
        grid = cus;
    }
    if (grid < 0) return;
    if (hipMemsetAsync((char*)d_ws + WS_BAR, 0, BAR_BYTES, stream) != hipSuccess) { fprintf(stderr, "kernel_launch: hipMemsetAsync failed\n"); return; }
    Params p{};
    for (int i = 0; i < 20; ++i) p.in[i] = (const float*)d_in[i];
    p.out = (float*)d_out; p.ws = (unsigned char*)d_ws;
    void* args[] = {&p};
    hipError_t e = hipLaunchCooperativeKernel((const void*)mega_fwd, dim3(grid), dim3(512), args, LDS_BYTES, stream);
    if (e != hipSuccess) fprintf(stderr, "kernel_launch: cooperative launch failed: %s (grid %d)\n", hipGetErrorString(e), grid);
}
```

```cpp
#include <hip/hip_runtime.h>
#include <hip/hip_cooperative_groups.h>
#include <cstdio>
#include <cstdint>
namespace cg = cooperative_groups;

#define LAS __attribute__((address_space(3)))
typedef unsigned short bf16_t;
typedef short bf16x8 __attribute__((ext_vector_type(8)));
typedef short s16x4 __attribute__((ext_vector_type(4)));
typedef float f32x4 __attribute__((ext_vector_type(4)));
typedef float f32x16 __attribute__((ext_vector_type(16)));
typedef unsigned u32x4 __attribute__((ext_vector_type(4)));

constexpr int DM = 1024, TP = 16384, TS = 32768, TT = TP + TS, SS_LEN = 2048, NMEMROWS = 17 * 256;
constexpr int NIN = 1792;
constexpr float EPS = 1e-6f;
constexpr size_t MiB = 1u << 20, KiB = 1024;
constexpr size_t WS_SS2 = 0, WS_SS3 = 196608;
constexpr size_t WS_ROPE = 512 * KiB;
constexpr size_t WS_F1P = 640 * KiB, WS_F2P = 768 * KiB, WS_F1S = 832 * KiB, WS_F2S = 840 * KiB;
constexpr size_t WS_WIN = 1 * MiB, WS_WOUT = WS_WIN + 3584 * KiB, WS_WCQ = WS_WOUT + 2 * MiB, WS_WCKV = WS_WCQ + 2 * MiB,
                 WS_WCO = WS_WCKV + 4 * MiB, WS_WUP = WS_WCO + 2 * MiB, WS_WDN = WS_WUP + 8 * MiB;
constexpr size_t WS_MN = 31 * MiB, WS_KC = WS_MN + 8704 * KiB, WS_VT = WS_KC + 8704 * KiB;
constexpr size_t SLOT_A = 64 * MiB, SLOT_B = 160 * MiB, SLOT_C = 256 * MiB, SLOT_D = 352 * MiB, SLOT_E = 448 * MiB;
constexpr size_t WS_XN1 = SLOT_A, WS_PB = SLOT_B, WS_TMP = SLOT_B + 48 * MiB, WS_QB = SLOT_C, WS_KB = SLOT_E  , WS_VB = SLOT_E;
constexpr size_t WS_MIX = SLOT_A, WS_XB2 = SLOT_B, WS_QC = SLOT_C, WS_PC = SLOT_D, WS_OC = SLOT_A, WS_XB3 = SLOT_B, WS_H = SLOT_C;
constexpr size_t WS_BAR = 896 * KiB, BAR_BYTES = 16 * KiB;
constexpr size_t WS_NEED = 512 * MiB;
constexpr int LDS_BYTES = 147456, ELDS_OFF = 131072, MISC_OFF = ELDS_OFF + 12288;

__device__ __forceinline__ unsigned cvt_pk_bf16(float lo, float hi) { unsigned r; asm volatile("v_cvt_pk_bf16_f32 %0, %1, %2" : "=v"(r) : "v"(lo), "v"(hi)); return r; }
__device__ __forceinline__ unsigned f2bf(float f) { unsigned u = __builtin_bit_cast(unsigned, f); return (u + 0x7fffu + ((u >> 16) & 1u)) >> 16; }
__device__ __forceinline__ unsigned pk2(float lo, float hi) { return f2bf(lo) | (f2bf(hi) << 16); }
__device__ __forceinline__ float wave_sum(float v) {
#pragma unroll
    for (int o = 1; o < 64; o <<= 1) v += __shfl_xor(v, o);
    return v;
}
__device__ __forceinline__ int opaque_tid(int wave) { int t; asm volatile("v_mbcnt_lo_u32_b32 %0, -1, 0\n\tv_mbcnt_hi_u32_b32 %0, -1, %0\n\tv_or_b32 %0, %1, %0" : "=&v"(t) : "s"(wave << 6)); return t; }
__device__ __forceinline__ unsigned char* ws_launder(unsigned char* p) { asm volatile("" : "+s"(p)); return p; }
#define LDS_WAIT() asm volatile("s_waitcnt lgkmcnt(0)" ::: "memory")
#define RAW_BAR() do { asm volatile("s_waitcnt lgkmcnt(0)" ::: "memory"); __builtin_amdgcn_s_barrier(); asm volatile("" ::: "memory"); } while (0)

namespace pg8 {
constexpr int BM = 256, BK = 64, HALF = 128, HTB = HALF * BK * 2, STAGE_BYTES = 8 * HTB, NXCD = 8, WGM = 8;
__host__ __device__ __forceinline__ int lds_byte(int r, int c) { const int st = (r >> 4) * 2 + (c >> 5), rr = r & 15, cc = c & 31, ob = rr * 64 + cc * 2; return st * 1024 + (ob ^ (((ob >> 9) & 1) << 5)); }
__host__ __device__ __forceinline__ void stage_rc(int b, int& R, int& C) { const int st = b / 1024, sb = b % 1024, swz = sb ^ (((sb >> 9) & 1) << 5); R = (st >> 1) * 16 + swz / 64; C = (st & 1) * 32 + (swz % 64) / 2; }
__host__ __device__ __forceinline__ int perm32(int rho) { const int n = rho >> 4, i = rho & 15; return 8 * (i >> 2) + 4 * n + (i & 3); }

struct Unit { int pm, pn, gid; };
__device__ __forceinline__ void map_tile(int wgid, int nM, int nN, int& pm, int& pn) {
    const int nwg = nM * nN;
    { const int q = nwg / NXCD, r = nwg % NXCD, xcd = wgid % NXCD, off = wgid / NXCD; wgid = (xcd < r ? xcd * (q + 1) : r * (q + 1) + (xcd - r) * q) + off; }
    const int nig = WGM * nN, gid = wgid / nig, fm = gid * WGM, gsz = (nM - fm) < WGM ? (nM - fm) : WGM;
    pm = fm + ((wgid % nig) % gsz); pn = (wgid % nig) / gsz;
}
template <class Epi, class Pol>
__device__ __forceinline__ void gemm_phase(const int wave_id, LAS unsigned char* lds, LAS unsigned char* elds, const Pol& S, const Epi& E, const int K, const int lda, const int ldb) {
    const int tid = opaque_tid(wave_id), wid = __builtin_amdgcn_readfirstlane(tid >> 6), lane = tid & 63, wr = wid >> 2, wc = wid & 3, fr = lane & 15, fq = lane >> 4;
    int nt = K / BK; asm volatile("" : "+s"(nt));
    unsigned voffA[2], voffB[2];
#pragma unroll
    for (int i = 0; i < 2; ++i) { int R, C; stage_rc(tid * 16 + i * 8192, R, C); const int Rb = (R & ~31) + perm32(R & 31);
        voffA[i] = (unsigned)(R * lda + C) * 2u; voffB[i] = (unsigned)(Rb * ldb + C) * 2u; }
    const size_t kstep = (size_t)(BK * 2);
    const size_t hA = (size_t)HALF * lda * 2, hB = (size_t)HALF * ldb * 2;
    const unsigned ldsw = (unsigned)wid * 1024u;
    const int aoff = lds_byte(wr * 64 + fr, fq * 8), boff = lds_byte(wc * 32 + fr, fq * 8);
#define PG8_SA(b, h) (((b) * 2 + (h)) * HTB)
#define PG8_SB(b, h) ((4 + (b) * 2 + (h)) * HTB)
#define PG8_STAGE(bufoff, gbase, voff) do { _Pragma("unroll") for (int _i = 0; _i < 2; ++_i) \
        __builtin_amdgcn_global_load_lds((const unsigned*)((const char*)(gbase) + (voff)[_i]), (LAS unsigned*)(lds + (bufoff) + ldsw + _i * 8192), 16, 0, 0); } while (0)
#define PG8_LDA(dst, b, h) do { _Pragma("unroll") for (int m = 0; m < 4; ++m) _Pragma("unroll") for (int k = 0; k < 2; ++k) dst[m][k] = *(const LAS bf16x8*)(lds + PG8_SA(b, h) + aoff + m * 2048 + k * 1024); } while (0)
#define PG8_LDB(dst, b, h) do { _Pragma("unroll") for (int n = 0; n < 2; ++n) _Pragma("unroll") for (int k = 0; k < 2; ++k) dst[n][k] = *(const LAS bf16x8*)(lds + PG8_SB(b, h) + boff + n * 2048 + k * 1024); } while (0)
#define PG8_MMA(ai, bj, At, Bt) do { __builtin_amdgcn_s_setprio(1); _Pragma("unroll") for (int m = 0; m < 4; ++m) _Pragma("unroll") for (int n = 0; n < 2; ++n) _Pragma("unroll") for (int k = 0; k < 2; ++k) \
        acc[ai][bj][m][n] = __builtin_amdgcn_mfma_f32_16x16x32_bf16(Bt[n][k], At[m][k], acc[ai][bj][m][n], 0, 0, 0); __builtin_amdgcn_s_setprio(0); } while (0)
#define PG8_WAIT_V(n) asm volatile("s_waitcnt vmcnt(" #n ")" ::: "memory")
#define PG8_WAIT_L(n) asm volatile("s_waitcnt lgkmcnt(" #n ")" ::: "memory")
#define PG8_BAR __builtin_amdgcn_s_barrier()
#define PG8_SCHED __builtin_amdgcn_sched_barrier(0)
    Unit cur, nxt; int ui = 0;
    if (!S.next(0, cur)) return;
    f32x4 acc[2][2][4][2];
#pragma unroll
    for (int a = 0; a < 2; ++a)
#pragma unroll
        for (int b = 0; b < 2; ++b)
#pragma unroll
            for (int m = 0; m < 4; ++m)
#pragma unroll
                for (int n = 0; n < 2; ++n) acc[a][b][m][n] = (f32x4){0.f, 0.f, 0.f, 0.f};
    bf16x8 At[4][2], B0[2][2], B1[2][2];
    const char* cA = S.a_base(cur); const char* cB = S.b_base(cur);
    PG8_STAGE(PG8_SB(0, 0), cB, voffB); PG8_STAGE(PG8_SB(0, 1), cB + hB, voffB); PG8_STAGE(PG8_SA(0, 0), cA, voffA); PG8_STAGE(PG8_SA(0, 1), cA + hA, voffA);
    if (wr == 1) PG8_BAR;
    PG8_WAIT_V(2); PG8_BAR;
    PG8_STAGE(PG8_SB(1, 0), cB + kstep, voffB); PG8_STAGE(PG8_SA(1, 0), cA + kstep, voffA); PG8_STAGE(PG8_SB(1, 1), cB + hB + kstep, voffB);
    PG8_WAIT_V(6); PG8_BAR;
    for (;;) {
        const bool has_next = S.next(ui + 1, nxt);
        const char* nA = has_next ? S.a_base(nxt) : cA; const char* nB = has_next ? S.b_base(nxt) : cB;
        for (int t = 0; t < nt; t += 2) {
            const bool last = (t == nt - 2);
            const char* a1 = cA + (size_t)(t + 1) * kstep;
            const char* a2 = last ? nA : cA + (size_t)(t + 2) * kstep; const char* b2 = last ? nB : cB + (size_t)(t + 2) * kstep;
            const char* a3 = a2 + kstep; const char* b3 = b2 + kstep;
            PG8_LDB(B0, 0, 0); PG8_LDB(B1, 0, 1); PG8_SCHED; PG8_LDA(At, 0, 0); PG8_STAGE(PG8_SA(1, 1), a1 + hA, voffA);
            PG8_WAIT_V(8); PG8_WAIT_L(0); PG8_BAR; PG8_MMA(0, 0, At, B0); PG8_MMA(0, 1, At, B1); PG8_BAR; PG8_SCHED;
            PG8_LDA(At, 0, 1); PG8_STAGE(PG8_SB(0, 0), b2, voffB); PG8_STAGE(PG8_SB(0, 1), b2 + hB, voffB); PG8_STAGE(PG8_SA(0, 0), a2, voffA);
            PG8_WAIT_V(8); PG8_WAIT_L(0); PG8_BAR; PG8_MMA(1, 0, At, B0); PG8_MMA(1, 1, At, B1); PG8_BAR; PG8_SCHED;
            PG8_LDB(B0, 1, 0); PG8_LDB(B1, 1, 1); PG8_SCHED; PG8_LDA(At, 1, 0); PG8_STAGE(PG8_SA(0, 1), a2 + hA, voffA);
            PG8_WAIT_V(8); PG8_WAIT_L(0); PG8_BAR; PG8_MMA(0, 0, At, B0); PG8_MMA(0, 1, At, B1); PG8_BAR; PG8_SCHED;
            PG8_LDA(At, 1, 1); PG8_STAGE(PG8_SB(1, 0), b3, voffB); PG8_STAGE(PG8_SB(1, 1), b3 + hB, voffB); PG8_STAGE(PG8_SA(1, 0), a3, voffA);
            PG8_WAIT_V(8); PG8_WAIT_L(0); PG8_BAR; PG8_MMA(1, 0, At, B0); PG8_MMA(1, 1, At, B1); PG8_BAR; PG8_SCHED;
        }
        if (wr == 0) PG8_BAR;
        { int fr2 = fr, fq2 = fq; asm volatile("" : "+v"(fr2), "+v"(fq2));
          E(acc, cur, wr, wc, fr2, fq2, elds); }
        if (!has_next) break;
#pragma unroll
        for (int a = 0; a < 2; ++a)
#pragma unroll
            for (int b = 0; b < 2; ++b)
#pragma unroll
                for (int m = 0; m < 4; ++m)
#pragma unroll
                    for (int n = 0; n < 2; ++n) acc[a][b][m][n] = (f32x4){0.f, 0.f, 0.f, 0.f};
        cur = nxt; cA = nA; cB = nB; ++ui;
        if (wr == 1) PG8_BAR;
    }
    PG8_WAIT_V(0);
    PG8_BAR;
#undef PG8_SA
#undef PG8_SB
#undef PG8_STAGE
#undef PG8_LDA
#undef PG8_LDB
#undef PG8_MMA
#undef PG8_WAIT_V
#undef PG8_WAIT_L
#undef PG8_BAR
#undef PG8_SCHED
}

__device__ __forceinline__ int batch_of_pm(int pm) { return pm < 64 ? 0 : 1 + ((pm - 64) >> 3); }
struct PolSimple {
    const bf16_t* A; const bf16_t* Bt; int nM, nN, lda, ldb, G, c;
    __device__ __forceinline__ bool next(int i, Unit& u) const { const long L = (long)i * G + c; if (L >= (long)nM * nN) return false; map_tile((int)L, nM, nN, u.pm, u.pn); u.gid = 0; return true; }
    __device__ __forceinline__ const char* a_base(const Unit& u) const { return (const char*)(A + (size_t)u.pm * 256 * lda); }
    __device__ __forceinline__ const char* b_base(const Unit& u) const { return (const char*)(Bt + (size_t)u.pn * 256 * ldb); }
};
struct PolP1 {
    const char* ws; int G, c;
    __device__ __forceinline__ bool next(int i, Unit& u) const {
        long L = (long)i * G + c;
        if (L < 1344) { map_tile((int)L, 192, 7, u.pm, u.pn); u.gid = 0; return true; } L -= 1344;
        if (L < 68) { map_tile((int)L, 17, 4, u.pm, u.pn); u.gid = 1; return true; } L -= 68;
        if (L < 68) { map_tile((int)L, 4, 17, u.pm, u.pn); u.gid = 2; return true; }
        return false;
    }
    __device__ __forceinline__ const char* a_base(const Unit& u) const {
        const size_t off = u.gid == 0 ? WS_XN1 : (u.gid == 1 ? WS_MN : WS_WCKV + (size_t)1024 * 1024 * 2); return ws + off + (size_t)u.pm * 256 * 1024 * 2; }
    __device__ __forceinline__ const char* b_base(const Unit& u) const {
        const size_t off = u.gid == 0 ? WS_WIN : (u.gid == 1 ? WS_WCKV : WS_MN); return ws + off + (size_t)u.pn * 256 * 1024 * 2; }
};
struct PolS {
    const bf16_t* QC; const bf16_t* KC; int G, c;
    __device__ __forceinline__ bool next(int i, Unit& u) const { const long L = (long)i * G + c; if (L >= 768) return false; map_tile((int)L, 192, 4, u.pm, u.pn); u.gid = 0; return true; }
    __device__ __forceinline__ const char* a_base(const Unit& u) const { return (const char*)(QC + (size_t)u.pm * 256 * 1024 + u.pn * 256); }
    __device__ __forceinline__ const char* b_base(const Unit& u) const { return (const char*)(KC + (size_t)batch_of_pm(u.pm) * 256 * 1024 + u.pn * 256); }
};
struct PolPV {
    const bf16_t* PC; const bf16_t* VT; int G, c;
    __device__ __forceinline__ bool next(int i, Unit& u) const { const long L = (long)i * G + c; if (L >= 768) return false; map_tile((int)L, 192, 4, u.pm, u.pn); u.gid = 0; return true; }
    __device__ __forceinline__ const char* a_base(const Unit& u) const { return (const char*)(PC + (size_t)u.pm * 256 * 1024 + u.pn * 256); }
    __device__ __forceinline__ const char* b_base(const Unit& u) const { return (const char*)(VT + (size_t)u.pn * 256 * NMEMROWS + batch_of_pm(u.pm) * 256); }
};

typedef f32x4 Acc[2][2][4][2];
__device__ __forceinline__ float dot4(f32x4 x) { return (x[0] * x[0] + x[1] * x[1]) + (x[2] * x[2] + x[3] * x[3]); }
__device__ __forceinline__ float sum4(f32x4 x) { return (x[0] + x[1]) + (x[2] + x[3]); }
__device__ __forceinline__ void st_bf16x8(bf16_t* p, f32x4 v0, f32x4 v1) {
    u32x4 w; w.x = cvt_pk_bf16(v0[0], v0[1]); w.y = cvt_pk_bf16(v0[2], v0[3]); w.z = cvt_pk_bf16(v1[0], v1[1]); w.w = cvt_pk_bf16(v1[2], v1[3]); *(u32x4*)p = w; }
__device__ __forceinline__ void st_bf16x8_q4(bf16_t* p, f32x4 v0, f32x4 v1) {
    u32x4 w; w.x = cvt_pk_bf16(v0[0], v0[1]); w.y = cvt_pk_bf16(v0[2], v0[3]); w.z = cvt_pk_bf16(v1[0], v1[1]); w.w = cvt_pk_bf16(v1[2], v1[3]);
    w = (w + 0x00080008u) & 0xFFF0FFF0u; *(u32x4*)p = w; }
template <bool Q4 = false>
__device__ __forceinline__ void epi_plain(const Acc& acc, int row0, int wr, int wc, int fr, int fq, bf16_t* dst, size_t ldd, int dcol0, int bjs = 128) {
#pragma unroll
    for (int ai = 0; ai < 2; ++ai)
#pragma unroll
        for (int m = 0; m < 4; ++m) { bf16_t* rp = dst + (size_t)(row0 + ai * 128 + wr * 64 + m * 16 + fr) * ldd + dcol0 + wc * 32 + 8 * fq;
#pragma unroll
            for (int bj = 0; bj < 2; ++bj) { if (Q4) st_bf16x8_q4(rp + bj * bjs, acc[ai][bj][m][0], acc[ai][bj][m][1]); else st_bf16x8(rp + bj * bjs, acc[ai][bj][m][0], acc[ai][bj][m][1]); } }
}
template <int MODE>
__device__ __forceinline__ void epi_rowred256(Acc& acc, int row0, int wr, int wc, int fr, int fq, LAS unsigned char* el,
                                              const float* rs, const float* g, float extra, bf16_t* dst, size_t ldd, int dcol0) {
    LAS float* P = (LAS float*)el;
    float red[2][4];
#pragma unroll
    for (int ai = 0; ai < 2; ++ai)
#pragma unroll
        for (int m = 0; m < 4; ++m) {
            float pre = 1.f; if (MODE == 0 && rs) pre = rsqrtf(rs[row0 + ai * 128 + wr * 64 + m * 16 + fr] * (1.f / 1024.f) + EPS);
            float s = 0.f;
#pragma unroll
            for (int bj = 0; bj < 2; ++bj)
#pragma unroll
                for (int n = 0; n < 2; ++n) { f32x4 x = acc[ai][bj][m][n];
                    if (MODE == 0) { x = x * pre; s += dot4(x); } else { x[0] = __expf(x[0]); x[1] = __expf(x[1]); x[2] = __expf(x[2]); x[3] = __expf(x[3]); s += sum4(x); }
                    acc[ai][bj][m][n] = x; }
            s += __shfl_xor(s, 16); s += __shfl_xor(s, 32);
            red[ai][m] = s;
        }
    if (fq == 0) {
#pragma unroll
        for (int ai = 0; ai < 2; ++ai)
#pragma unroll
            for (int m = 0; m < 4; ++m) P[(ai * 128 + wr * 64 + m * 16 + fr) * 4 + wc] = red[ai][m];
    }
    RAW_BAR();
#pragma unroll
    for (int ai = 0; ai < 2; ++ai)
#pragma unroll
        for (int m = 0; m < 4; ++m) { const int rl = ai * 128 + wr * 64 + m * 16 + fr;
            const f32x4 t = *(const LAS f32x4*)&P[rl * 4]; const float tot = (t[0] + t[1]) + (t[2] + t[3]);
            const float sc = MODE == 0 ? rsqrtf(tot * (1.f / 256.f) + EPS) * extra : 1.f / tot;
            bf16_t* rp = dst + (size_t)(row0 + rl) * ldd + dcol0 + wc * 32 + 8 * fq;
#pragma unroll
            for (int bj = 0; bj < 2; ++bj) { f32x4 v0 = acc[ai][bj][m][0] * sc, v1 = acc[ai][bj][m][1] * sc;
                if (MODE == 0) { const float* gp = g + bj * 128 + wc * 32 + 8 * fq; v0 = v0 * *(const f32x4*)gp; v1 = v1 * *(const f32x4*)(gp + 4); }
                st_bf16x8(rp + bj * 128, v0, v1); } }
}

struct EpiP1 {
    bf16_t *PB, *QB, *KB, *VB, *KC, *VT; const float *g_q, *g_k, *g_ck, *rope;
    __device__ __forceinline__ void operator()(Acc& acc, const Unit& u, int wr, int wc, int fr, int fq, LAS unsigned char* el) const {
        const int row0 = u.pm * 256;
        if (u.gid == 1) { epi_rowred256<0>(acc, row0, wr, wc, fr, fq, el, nullptr, g_ck, 0.0625f, KC, 1024, u.pn * 256); return; }
        if (u.gid == 2) { epi_plain(acc, row0, wr, wc, fr, fq, VT, NMEMROWS, u.pn * 256); return; }
        if (u.pn < 2) { epi_plain(acc, row0, wr, wc, fr, fq, PB, 512, u.pn * 256); return; }
        if (u.pn == 6) { epi_plain<true>(acc, row0, wr, wc, fr, fq, KB, 512, 128, 256); return; }
        const bool isk = (u.pn == 5);
        const float* gain = isk ? g_k : g_q; bf16_t* dst = isk ? KB : QB; const size_t ldd = isk ? 512 : 768; const int hcol0 = isk ? 0 : (u.pn - 2) * 256; const int bjs = isk ? 256 : 128;
        LAS float* P = (LAS float*)el;
#pragma unroll
        for (int ai = 0; ai < 2; ++ai)
#pragma unroll
            for (int m = 0; m < 4; ++m)
#pragma unroll
                for (int bj = 0; bj < 2; ++bj) { float s = dot4(acc[ai][bj][m][0]) + dot4(acc[ai][bj][m][1]);
                    s += __shfl_xor(s, 16); s += __shfl_xor(s, 32);
                    if (fq == 0) P[((ai * 128 + wr * 64 + m * 16 + fr) * 2 + bj) * 4 + wc] = s; }
        RAW_BAR();
        const int blk = wc >> 1, j0 = 16 * (wc & 1) + 4 * fq;
        const f32x4 ga = *(const f32x4*)(gain + 64 * blk + j0), gb = *(const f32x4*)(gain + 64 * blk + 32 + j0);
#pragma unroll
        for (int ai = 0; ai < 2; ++ai)
#pragma unroll
            for (int m = 0; m < 4; ++m) { const int rl = ai * 128 + wr * 64 + m * 16 + fr, row = row0 + rl;
                const int pos = row < TP ? row : ((row - TP) & (SS_LEN - 1)); const int v = blk == 0 ? (pos >> 6) : (pos & 63);
                const float* rp = rope + (size_t)(v * 32 + j0) * 2; const f32x4 cs0 = *(const f32x4*)rp, cs1 = *(const f32x4*)(rp + 4);
                const f32x4 cc = (f32x4){cs0[0], cs0[2], cs1[0], cs1[2]}, sn = (f32x4){cs0[1], cs0[3], cs1[1], cs1[3]};
#pragma unroll
                for (int bj = 0; bj < 2; ++bj) { const f32x4 t = *(const LAS f32x4*)&P[(rl * 2 + bj) * 4];
                    const float rstd = rsqrtf(((t[0] + t[1]) + (t[2] + t[3])) * (1.f / 128.f) + EPS);
                    const f32x4 a = acc[ai][bj][m][0] * rstd * ga, b = acc[ai][bj][m][1] * rstd * gb;
                    st_bf16x8_q4(dst + (size_t)row * ldd + hcol0 + bj * bjs + wc * 32 + 8 * fq, a * cc - b * sn, b * cc + a * sn); } }
    }
};
struct EpiResid {
    const float* base0; const float* base1; float* out; bf16_t* xb; float* ss; int row_off;
    __device__ __forceinline__ void operator()(Acc& acc, const Unit& u, int wr, int wc, int fr, int fq, LAS unsigned char* el) const {
#pragma unroll
        for (int ai = 0; ai < 2; ++ai)
#pragma unroll
            for (int m = 0; m < 4; ++m) { const int row = row_off + u.pm * 256 + ai * 128 + wr * 64 + m * 16 + fr;
                const float* bp = row < TP ? base0 + (size_t)row * DM : base1 + (size_t)(row - TP) * DM; float s = 0.f;
#pragma unroll
                for (int bj = 0; bj < 2; ++bj) { const int col = u.pn * 256 + bj * 128 + wc * 32 + 8 * fq;
                    const f32x4 o0 = *(const f32x4*)(bp + col) + acc[ai][bj][m][0], o1 = *(const f32x4*)(bp + col + 4) + acc[ai][bj][m][1];
                    float* op = out + (size_t)row * DM + col; *(f32x4*)op = o0; *(f32x4*)(op + 4) = o1;
                    if (xb) { st_bf16x8(xb + (size_t)row * DM + col, o0, o1); s += dot4(o0) + dot4(o1); } }
                if (ss) { s += __shfl_xor(s, 16); s += __shfl_xor(s, 32); if (fq == 0) atomicAdd(ss + row, s); } }
    }
};
struct EpiCq { const float* ss2; const float* g_cq; bf16_t* QC;
    __device__ __forceinline__ void operator()(Acc& acc, const Unit& u, int wr, int wc, int fr, int fq, LAS unsigned char* el) const {
        epi_rowred256<0>(acc, u.pm * 256, wr, wc, fr, fq, el, ss2, g_cq, 1.f, QC, 1024, u.pn * 256); } };
struct EpiSoftmax { bf16_t* PC;
    __device__ __forceinline__ void operator()(Acc& acc, const Unit& u, int wr, int wc, int fr, int fq, LAS unsigned char* el) const {
        epi_rowred256<1>(acc, u.pm * 256, wr, wc, fr, fq, el, nullptr, nullptr, 1.f, PC, 1024, u.pn * 256); } };
struct EpiPlain { bf16_t* O; size_t ldd;
    __device__ __forceinline__ void operator()(Acc& acc, const Unit& u, int wr, int wc, int fr, int fq, LAS unsigned char* el) const {
        epi_plain(acc, u.pm * 256, wr, wc, fr, fq, O, ldd, u.pn * 256); } };
struct EpiUp { const float* ss3; bf16_t* H; int row_off;
    __device__ __forceinline__ void operator()(Acc& acc, const Unit& u, int wr, int wc, int fr, int fq, LAS unsigned char* el) const {
#pragma unroll
        for (int ai = 0; ai < 2; ++ai)
#pragma unroll
            for (int m = 0; m < 4; ++m) { const int rl = u.pm * 256 + ai * 128 + wr * 64 + m * 16 + fr;
                const float rstd = rsqrtf(ss3[row_off + rl] * (1.f / 1024.f) + EPS);
                bf16_t* rp = H + (size_t)rl * 4096 + u.pn * 256 + wc * 32 + 8 * fq;
#pragma unroll
                for (int bj = 0; bj < 2; ++bj) { f32x4 v0 = acc[ai][bj][m][0] * rstd, v1 = acc[ai][bj][m][1] * rstd;
#pragma unroll
                    for (int i = 0; i < 4; ++i) { const float a = fmaxf(v0[i], 0.f), b = fmaxf(v1[i], 0.f); v0[i] = a * a; v1[i] = b * b; }
                    st_bf16x8(rp + bj * 128, v0, v1); } }
    }
};
}

namespace att {
constexpr int D = 128, NW = 8, QBLK = 32, KVBLK = 64;
constexpr float SCALE = 0.088388347648318440f;
constexpr float THR = 8.f;
constexpr int LDQ = 768, LDK = 512, LDO = 1024;
constexpr size_t SHM_V = KVBLK * D * 2, SHM_K = KVBLK * D * 2, SHM_ATTN = 2 * SHM_V + 2 * SHM_K + NW * 64 * 4;
#define KSWZ(row, colB) ((row) * 256 + ((colB) ^ (((row) & 7) << 4)))
#define SBAR() __builtin_amdgcn_sched_barrier(0)
__device__ __forceinline__ int crow(int r, int hi) { return (r & 3) + 8 * (r >> 2) + 4 * hi; }
__device__ __forceinline__ unsigned cvtpk(float lo, float hi) { unsigned r; asm volatile("v_cvt_pk_bf16_f32 %0, %1, %2" : "=v"(r) : "v"(lo), "v"(hi)); return r; }
template <bool ST>
__device__ __forceinline__ void partialSM(f32x16& p0, f32x16& p1, float& m_reg, float& mn, float& alpha, float negBC) {
  constexpr float C = SCALE * 1.4426950408889634f;
  float mnC;
  if constexpr (ST) { mn = 0.f; alpha = 1.f; mnC = negBC; }
  else {
  float pmax = p0[0]; for (int r = 1; r < 16; ++r) pmax = fmaxf(pmax, p0[r]); for (int r = 0; r < 16; ++r) pmax = fmaxf(pmax, p1[r]);
  { auto rr = __builtin_amdgcn_permlane32_swap(__float_as_uint(pmax), __float_as_uint(pmax), false, false);
    pmax = fmaxf(__uint_as_float(rr[0]), __uint_as_float(rr[1])); }
  if (__builtin_expect(__all(pmax - m_reg <= THR / SCALE), 1)) { mn = m_reg; alpha = 1.f; }
  else { mn = fmaxf(m_reg, pmax); alpha = __builtin_amdgcn_exp2f((m_reg - mn) * C); m_reg = mn; }
  mnC = -mn * C;
  }
  for (int r = 0; r < 16; ++r) p0[r] = fmaf(p0[r], C, mnC); for (int r = 0; r < 16; ++r) p1[r] = fmaf(p1[r], C, mnC);
  for (int r = 0; r < 16; ++r) p0[r] = __builtin_amdgcn_exp2f(p0[r]);
}
__device__ __forceinline__ void finishSM(f32x16& p0, f32x16& p1, float alpha, float& l_reg, bf16x8& pa0, bf16x8& pa1, bf16x8& pa2, bf16x8& pa3) {
  for (int r = 0; r < 16; ++r) p1[r] = __builtin_amdgcn_exp2f(p1[r]);
  float ps = 0; for (int r = 0; r < 16; ++r) ps += p0[r]; for (int r = 0; r < 16; ++r) ps += p1[r];
  { auto rr = __builtin_amdgcn_permlane32_swap(__float_as_uint(ps), __float_as_uint(ps), false, false);
    ps = __uint_as_float(rr[0]) + __uint_as_float(rr[1]); }
  l_reg = l_reg * alpha + ps;
#define PK4(P, BASE, OUT) do { unsigned a0 = cvtpk(P[BASE + 0], P[BASE + 1]), a1 = cvtpk(P[BASE + 2], P[BASE + 3]);   \
    unsigned b0 = cvtpk(P[BASE + 4], P[BASE + 5]), b1 = cvtpk(P[BASE + 6], P[BASE + 7]);                              \
    auto r0 = __builtin_amdgcn_permlane32_swap(a0, b0, false, false); auto r1 = __builtin_amdgcn_permlane32_swap(a1, b1, false, false); \
    u32x4 w = {r0[0], r1[0], r0[1], r1[1]}; OUT = *reinterpret_cast<bf16x8*>(&w); } while (0)
  PK4(p0, 0, pa0); PK4(p0, 8, pa1); PK4(p1, 0, pa2); PK4(p1, 8, pa3);
#undef PK4
}
__device__ __forceinline__ void qkt(f32x16& p0, f32x16& p1, const LAS unsigned char* Ks, const bf16x8* qr, int r32, int hi) {
  p0 = f32x16{}; p1 = f32x16{};
  for (int d0 = 0; d0 < 8; ++d0) { int cb = (d0 * 16 + hi * 8) * 2;
    bf16x8 b0 = *reinterpret_cast<const LAS bf16x8*>(Ks + KSWZ(r32, cb));
    bf16x8 b1 = *reinterpret_cast<const LAS bf16x8*>(Ks + KSWZ(32 + r32, cb));
    p0 = __builtin_amdgcn_mfma_f32_32x32x16_bf16(b0, qr[d0], p0, 0, 0, 0);
    p1 = __builtin_amdgcn_mfma_f32_32x32x16_bf16(b1, qr[d0], p1, 0, 0, 0); }
}
__device__ __forceinline__ int v_st(int k, int c) { const int kk = (k & ~0xC) | ((k & 4) << 1) | ((k & 8) >> 1); return ((kk >> 3) * 4 + (c >> 5)) * 512 + ((kk & 7) * 32 + (c & 31)) * 2; }
__device__ __forceinline__ int v_rd_base(int lane) { return ((lane & 3) << 3) | (((lane >> 2) & 3) << 6) | (((lane >> 4) & 1) << 5) | (((lane >> 5) & 1) << 8); }
constexpr int v_rd_off(int d0, int ks, int half) { return d0 * 512 + ks * 4096 + half * 2048; }
template <int OFF> __device__ __forceinline__ s16x4 tr_read(int vb) {
  s16x4 r; asm volatile("ds_read_b64_tr_b16 %0, %1 offset:%2" : "=&v"(r) : "v"(vb), "i"(OFF) : "memory"); return r;
}
template <int D0> __device__ __forceinline__ void pv_one(f32x16& od, int vb, bf16x8 pa0, bf16x8 pa1, bf16x8 pa2, bf16x8 pa3) {
  const s16x4 l0 = tr_read<v_rd_off(D0, 0, 0)>(vb), h0 = tr_read<v_rd_off(D0, 0, 1)>(vb), l1 = tr_read<v_rd_off(D0, 1, 0)>(vb), h1 = tr_read<v_rd_off(D0, 1, 1)>(vb);
  const s16x4 l2 = tr_read<v_rd_off(D0, 2, 0)>(vb), h2 = tr_read<v_rd_off(D0, 2, 1)>(vb), l3 = tr_read<v_rd_off(D0, 3, 0)>(vb), h3 = tr_read<v_rd_off(D0, 3, 1)>(vb);
  asm volatile("s_waitcnt lgkmcnt(0)" ::: "memory"); SBAR();
#define PK(L, H) (bf16x8){L[0], L[1], L[2], L[3], H[0], H[1], H[2], H[3]}
  od = __builtin_amdgcn_mfma_f32_32x32x16_bf16(pa0, PK(l0, h0), od, 0, 0, 0);
  od = __builtin_amdgcn_mfma_f32_32x32x16_bf16(pa1, PK(l1, h1), od, 0, 0, 0);
  od = __builtin_amdgcn_mfma_f32_32x32x16_bf16(pa2, PK(l2, h2), od, 0, 0, 0);
  od = __builtin_amdgcn_mfma_f32_32x32x16_bf16(pa3, PK(l3, h3), od, 0, 0, 0);
#undef PK
}
__device__ __forceinline__ void pv_d0(f32x16* o, int vb, bf16x8 pa0, bf16x8 pa1, bf16x8 pa2, bf16x8 pa3) {
  pv_one<0>(o[0], vb, pa0, pa1, pa2, pa3); pv_one<1>(o[1], vb, pa0, pa1, pa2, pa3); pv_one<2>(o[2], vb, pa0, pa1, pa2, pa3); pv_one<3>(o[3], vb, pa0, pa1, pa2, pa3);
}
template <bool ST>
__device__ __forceinline__ void attn_dense_body(float negBC, const bf16_t* __restrict__ Qb, const bf16_t* __restrict__ Kh, const bf16_t* __restrict__ Vh,
                                                bf16_t* __restrict__ Ob, int seq, LAS unsigned char* lds, LAS unsigned char* scr, int wave_id) {
  const int tid = opaque_tid(wave_id), wid = wave_id, lane = tid & 63, r32 = lane & 31, hi = lane >> 5;
  LAS float* ws = (LAS float*)scr + wid * 64; LAS float* li_l = ws; LAS float* al_l = ws + 32;
  float m_reg = -1e30f, l_reg = 0; f32x16 o[4] = {}; bf16x8 qr[8];
  const bf16_t* Qw = Qb + (long)(wid * QBLK + r32) * LDQ + hi * 8;
#pragma unroll
  for (int d0 = 0; d0 < 8; ++d0) qr[d0] = *reinterpret_cast<const bf16x8*>(Qw + d0 * 16);
  unsigned offK[2], offV[2];
#pragma unroll
  for (int i = 0; i < 2; ++i) { const int b = (i * 8 + wid) * 1024 + lane * 16;
    { const int row = b >> 8, colB = (b & 255) ^ ((row & 7) << 4); offK[i] = (unsigned)(row * LDK * 2 + colB); }
    { const int sub = b >> 9, within = b & 511, kk = (sub >> 2) * 8 + (within >> 6), k = (kk & ~0xC) | ((kk & 4) << 1) | ((kk & 8) >> 1), c = (sub & 3) * 32 + (within & 63) / 2;
      offV[i] = (unsigned)((k * LDK + c) * 2); } }
  const int vb0 = (int)(uintptr_t)(lds + 16384) + v_rd_base(lane);
#define AISSUE(t) do { const int _sl = (t) & 3; const char* _kp = (const char*)Kh + (size_t)(t) * (KVBLK * LDK * 2); const char* _vp = (const char*)Vh + (size_t)(t) * (KVBLK * LDK * 2); \
    _Pragma("unroll") for (int _i = 0; _i < 2; ++_i) { \
      __builtin_amdgcn_global_load_lds((const unsigned*)(_kp + offK[_i]), (LAS unsigned*)(lds + _sl * 32768 + (_i * 8 + wid) * 1024), 16, 0, 0); \
      __builtin_amdgcn_global_load_lds((const unsigned*)(_vp + offV[_i]), (LAS unsigned*)(lds + _sl * 32768 + 16384 + (_i * 8 + wid) * 1024), 16, 0, 0); } } while (0)
#define KPTR(t) ((const LAS unsigned char*)(lds + ((t) & 3) * 32768))
#define VBASE(t) (vb0 + ((t) & 3) * 32768)
#define WAITV4() asm volatile("s_waitcnt vmcnt(4)" ::: "memory")
#define WAITV0() asm volatile("s_waitcnt vmcnt(0)" ::: "memory")
#define RESC(a) do { if (!ST && __any((a) < 1.f)) { if (hi == 0) al_l[r32] = (a); asm volatile("s_waitcnt lgkmcnt(0)" ::: "memory"); \
    for (int d = 0; d < 4; ++d) for (int r = 0; r < 16; ++r) o[d][r] *= al_l[crow(r, hi)]; } } while (0)
  f32x16 pA0, pA1, pB0, pB1; float mnA, mnB, alA, alB; bf16x8 pa0, pa1, pa2, pa3; const int NT = seq / KVBLK;
  AISSUE(0); AISSUE(1);
  WAITV4(); RAW_BAR();
  AISSUE(2);
  qkt(pA0, pA1, KPTR(0), qr, r32, hi); partialSM<ST>(pA0, pA1, m_reg, mnA, alA, negBC);
  for (int j = 1; j + 1 < NT; j += 2) {
    WAITV4(); RAW_BAR();
    AISSUE(j + 2);
    SBAR(); qkt(pB0, pB1, KPTR(j), qr, r32, hi);
    finishSM(pA0, pA1, alA, l_reg, pa0, pa1, pa2, pa3); SBAR();
    pv_d0(o, VBASE(j - 1), pa0, pa1, pa2, pa3); partialSM<ST>(pB0, pB1, m_reg, mnB, alB, negBC);
    RESC(alB);
    WAITV4(); RAW_BAR();
    if (j + 3 < NT) AISSUE(j + 3);
    SBAR(); qkt(pA0, pA1, KPTR(j + 1), qr, r32, hi);
    finishSM(pB0, pB1, alB, l_reg, pa0, pa1, pa2, pa3); SBAR();
    pv_d0(o, VBASE(j), pa0, pa1, pa2, pa3); partialSM<ST>(pA0, pA1, m_reg, mnA, alA, negBC);
    RESC(alA);
  }
  WAITV0(); RAW_BAR();
  SBAR(); qkt(pB0, pB1, KPTR(NT - 1), qr, r32, hi);
  finishSM(pA0, pA1, alA, l_reg, pa0, pa1, pa2, pa3); SBAR();
  pv_d0(o, VBASE(NT - 2), pa0, pa1, pa2, pa3); partialSM<ST>(pB0, pB1, m_reg, mnB, alB, negBC);
  RESC(alB);
  finishSM(pB0, pB1, alB, l_reg, pa0, pa1, pa2, pa3); SBAR();
  pv_d0(o, VBASE(NT - 1), pa0, pa1, pa2, pa3);
  if (hi == 0) li_l[r32] = l_reg; asm volatile("s_waitcnt lgkmcnt(0)" ::: "memory");
  float rli[16];
#pragma unroll
  for (int r = 0; r < 16; ++r) rli[r] = __builtin_amdgcn_rcpf(li_l[crow(r, hi)]);
  bf16_t* Ow = Ob + (long)(wid * QBLK) * LDO;
#pragma unroll
  for (int r = 0; r < 16; ++r) { int orow = crow(r, hi);
    for (int d0 = 0; d0 < 4; ++d0) Ow[(long)orow * LDO + d0 * 32 + r32] = (bf16_t)f2bf(o[d0][r] * rli[r]); }
#undef AISSUE
#undef KPTR
#undef VBASE
#undef WAITV4
#undef WAITV0
#undef RESC
}

#define KSWZ16(row, colB) ((row) * 256 + ((colB) ^ (((row) & 15) << 4)))
typedef f32x4 S16[4][2];
constexpr int v16_off(int kk, int h, int db) { return kk * 8192 + h * 4096 + db * 256; }
__device__ __forceinline__ void qkt16(S16& s, const LAS unsigned char* Ks, const bf16x8 (&qf)[2][4], const int (&kb_dk)[4]) {
#pragma unroll
  for (int kb = 0; kb < 4; ++kb) { s[kb][0] = (f32x4){0.f, 0.f, 0.f, 0.f}; s[kb][1] = (f32x4){0.f, 0.f, 0.f, 0.f}; }
#pragma unroll
  for (int dk = 0; dk < 4; ++dk)
#pragma unroll
    for (int kb = 0; kb < 4; ++kb) { const bf16x8 kf = *reinterpret_cast<const LAS bf16x8*>(Ks + kb * 4096 + kb_dk[dk]);
      s[kb][0] = __builtin_amdgcn_mfma_f32_16x16x32_bf16(kf, qf[0][dk], s[kb][0], 0, 0, 0);
      s[kb][1] = __builtin_amdgcn_mfma_f32_16x16x32_bf16(kf, qf[1][dk], s[kb][1], 0, 0, 0); }
}
__device__ __forceinline__ void partialSM16(S16& s, float negBC) {
  (void)negBC;
#pragma unroll
  for (int kb = 0; kb < 2; ++kb)
#pragma unroll
    for (int qb = 0; qb < 2; ++qb)
#pragma unroll
      for (int r = 0; r < 4; ++r) s[kb][qb][r] = __builtin_amdgcn_exp2f(s[kb][qb][r]);
}
__device__ __forceinline__ void finishSM16(S16& s, bf16x8 (&pa)[2][2]) {
#pragma unroll
  for (int kb = 2; kb < 4; ++kb)
#pragma unroll
    for (int qb = 0; qb < 2; ++qb)
#pragma unroll
      for (int r = 0; r < 4; ++r) s[kb][qb][r] = __builtin_amdgcn_exp2f(s[kb][qb][r]);
#pragma unroll
  for (int qb = 0; qb < 2; ++qb)
#pragma unroll
    for (int kk = 0; kk < 2; ++kk) { const f32x4 x = s[2 * kk][qb], y = s[2 * kk + 1][qb];
      u32x4 w = {cvtpk(x[0], x[1]), cvtpk(x[2], x[3]), cvtpk(y[0], y[1]), cvtpk(y[2], y[3])}; w = w & 0xFFF0FFF0u;
      pa[qb][kk] = *reinterpret_cast<bf16x8*>(&w); }
}
template <int KK, int DQ> __device__ __forceinline__ void pv16_quad(f32x4 (&o)[2][8], int vb, const bf16x8 (&pa)[2][2]) {
  const s16x4 l0 = tr_read<v16_off(KK, 0, 4 * DQ + 0)>(vb), h0 = tr_read<v16_off(KK, 1, 4 * DQ + 0)>(vb), l1 = tr_read<v16_off(KK, 0, 4 * DQ + 1)>(vb), h1 = tr_read<v16_off(KK, 1, 4 * DQ + 1)>(vb);
  const s16x4 l2 = tr_read<v16_off(KK, 0, 4 * DQ + 2)>(vb), h2 = tr_read<v16_off(KK, 1, 4 * DQ + 2)>(vb), l3 = tr_read<v16_off(KK, 0, 4 * DQ + 3)>(vb), h3 = tr_read<v16_off(KK, 1, 4 * DQ + 3)>(vb);
  asm volatile("s_waitcnt lgkmcnt(0)" ::: "memory"); SBAR();
#define PK(L, H) (bf16x8){L[0], L[1], L[2], L[3], H[0], H[1], H[2], H[3]}
  o[0][4 * DQ + 0] = __builtin_amdgcn_mfma_f32_16x16x32_bf16(pa[0][KK], PK(l0, h0), o[0][4 * DQ + 0], 0, 0, 0);
  o[1][4 * DQ + 0] = __builtin_amdgcn_mfma_f32_16x16x32_bf16(pa[1][KK], PK(l0, h0), o[1][4 * DQ + 0], 0, 0, 0);
  o[0][4 * DQ + 1] = __builtin_amdgcn_mfma_f32_16x16x32_bf16(pa[0][KK], PK(l1, h1), o[0][4 * DQ + 1], 0, 0, 0);
  o[1][4 * DQ + 1] = __builtin_amdgcn_mfma_f32_16x16x32_bf16(pa[1][KK], PK(l1, h1), o[1][4 * DQ + 1], 0, 0, 0);
  o[0][4 * DQ + 2] = __builtin_amdgcn_mfma_f32_16x16x32_bf16(pa[0][KK], PK(l2, h2), o[0][4 * DQ + 2], 0, 0, 0);
  o[1][4 * DQ + 2] = __builtin_amdgcn_mfma_f32_16x16x32_bf16(pa[1][KK], PK(l2, h2), o[1][4 * DQ + 2], 0, 0, 0);
  o[0][4 * DQ + 3] = __builtin_amdgcn_mfma_f32_16x16x32_bf16(pa[0][KK], PK(l3, h3), o[0][4 * DQ + 3], 0, 0, 0);
  o[1][4 * DQ + 3] = __builtin_amdgcn_mfma_f32_16x16x32_bf16(pa[1][KK], PK(l3, h3), o[1][4 * DQ + 3], 0, 0, 0);
#undef PK
}
__device__ __forceinline__ void pv16(f32x4 (&o)[2][8], f32x4 (&lacc)[2], int vb, const bf16x8 (&pa)[2][2]) {
  pv16_quad<0, 0>(o, vb, pa); pv16_quad<0, 1>(o, vb, pa);
  const bf16x8 ones = {(short)0x3F80, (short)0x3F80, (short)0x3F80, (short)0x3F80, (short)0x3F80, (short)0x3F80, (short)0x3F80, (short)0x3F80};
  lacc[0] = __builtin_amdgcn_mfma_f32_16x16x32_bf16(pa[0][0], ones, lacc[0], 0, 0, 0); lacc[1] = __builtin_amdgcn_mfma_f32_16x16x32_bf16(pa[1][0], ones, lacc[1], 0, 0, 0);
  lacc[0] = __builtin_amdgcn_mfma_f32_16x16x32_bf16(pa[0][1], ones, lacc[0], 0, 0, 0); lacc[1] = __builtin_amdgcn_mfma_f32_16x16x32_bf16(pa[1][1], ones, lacc[1], 0, 0, 0);
  pv16_quad<1, 0>(o, vb, pa); pv16_quad<1, 1>(o, vb, pa);
}
__device__ __forceinline__ void attn_body16(float negBC, const bf16_t* __restrict__ Qb, const bf16_t* __restrict__ Kh, const bf16_t* __restrict__ Vh,
                                            bf16_t* __restrict__ Ob, int seq, LAS unsigned char* lds, LAS unsigned char* scr, int wave_id) {
  const int tid = opaque_tid(wave_id), wid = wave_id, lane = tid & 63, c = lane & 15, g = lane >> 4;
  f32x4 o[2][8];
#pragma unroll
  for (int qb = 0; qb < 2; ++qb)
#pragma unroll
    for (int db = 0; db < 8; ++db) o[qb][db] = (f32x4){0.f, 0.f, 0.f, 0.f};
  f32x4 lacc[2] = {(f32x4){0.f, 0.f, 0.f, 0.f}, (f32x4){0.f, 0.f, 0.f, 0.f}};
  unsigned offK[2], offV[2];
#pragma unroll
  for (int i = 0; i < 2; ++i) { const int b = (i * 8 + wid) * 1024 + lane * 16;
    { const int row = b >> 8, colB = (b & 255) ^ ((row & 15) << 4); offK[i] = (unsigned)(row * LDK * 2 + colB); }
    { const int sub = b >> 8, within = b & 255, key = (sub >> 3) * 8 + ((within >> 5) & 1) * 4 + (within >> 6), col = (sub & 7) * 16 + (within & 31) / 2;
      offV[i] = (unsigned)((key * LDK + col) * 2); } }
  int kb_dk[4];
#pragma unroll
  for (int dk = 0; dk < 4; ++dk) kb_dk[dk] = c * 256 + (((4 * dk + g) ^ c) << 4);
  const int vb0 = (int)(uintptr_t)(lds + 16384) + (g >> 1) * 2048 + ((lane >> 2) & 3) * 64 + (g & 1) * 32 + (lane & 3) * 8;
#define AISSUE(t) do { const int _sl = (t) & 3; const char* _kp = (const char*)Kh + (size_t)(t) * (KVBLK * LDK * 2); const char* _vp = (const char*)Vh + (size_t)(t) * (KVBLK * LDK * 2); \
    _Pragma("unroll") for (int _i = 0; _i < 2; ++_i) { \
      __builtin_amdgcn_global_load_lds((const unsigned*)(_kp + offK[_i]), (LAS unsigned*)(lds + _sl * 32768 + (_i * 8 + wid) * 1024), 16, 0, 0); \
      __builtin_amdgcn_global_load_lds((const unsigned*)(_vp + offV[_i]), (LAS unsigned*)(lds + _sl * 32768 + 16384 + (_i * 8 + wid) * 1024), 16, 0, 0); } } while (0)
#define KPTR(t) ((const LAS unsigned char*)(lds + ((t) & 3) * 32768))
#define VBASE(t) (vb0 + ((t) & 3) * 32768)
#define WAITV4() asm volatile("s_waitcnt vmcnt(4)" ::: "memory")
#define WAITV0() asm volatile("s_waitcnt vmcnt(0)" ::: "memory")
  S16 sA, sB; bf16x8 pa[2][2]; const int NT = seq / KVBLK;
  AISSUE(0); AISSUE(1);
  bf16x8 qf[2][4];
#pragma unroll
  for (int qb = 0; qb < 2; ++qb)
#pragma unroll
    for (int dk = 0; dk < 4; ++dk) { const u32x4 w = *reinterpret_cast<const u32x4*>(Qb + (long)(wid * 32 + 16 * qb + c) * LDQ + 32 * dk + 8 * g);
      constexpr float C = SCALE * 1.4426950408889634f; u32x4 v;
#pragma unroll
      for (int e = 0; e < 4; ++e) { const float lo = __uint_as_float(w[e] << 16), hi = __uint_as_float(w[e] & 0xffff0000u); v[e] = (cvtpk(lo * C, hi * C) + 0x00080008u) & 0xFFF0FFF0u; }
      qf[qb][dk] = *reinterpret_cast<const bf16x8*>(&v); }
  WAITV0(); RAW_BAR();
  AISSUE(2);
  qkt16(sA, KPTR(0), qf, kb_dk); partialSM16(sA, negBC);
  for (int j = 1; j + 1 < NT; j += 2) {
    WAITV4(); RAW_BAR();
    AISSUE(j + 2);
    SBAR(); qkt16(sB, KPTR(j), qf, kb_dk);
    finishSM16(sA, pa); SBAR();
    pv16(o, lacc, VBASE(j - 1), pa); partialSM16(sB, negBC);
    WAITV4(); RAW_BAR();
    if (j + 3 < NT) AISSUE(j + 3);
    SBAR(); qkt16(sA, KPTR(j + 1), qf, kb_dk);
    finishSM16(sB, pa); SBAR();
    pv16(o, lacc, VBASE(j), pa); partialSM16(sA, negBC);
  }
  WAITV0(); RAW_BAR();
  SBAR(); qkt16(sB, KPTR(NT - 1), qf, kb_dk);
  finishSM16(sA, pa); SBAR();
  pv16(o, lacc, VBASE(NT - 2), pa); partialSM16(sB, negBC);
  finishSM16(sB, pa); SBAR();
  pv16(o, lacc, VBASE(NT - 1), pa);
  (void)scr;
#pragma unroll
  for (int qb = 0; qb < 2; ++qb)
#pragma unroll
    for (int r = 0; r < 4; ++r) { const float rl = __builtin_amdgcn_rcpf(lacc[qb][r]);
      bf16_t* orow = Ob + (long)(wid * 32 + 16 * qb + 4 * g + r) * LDO + c;
#pragma unroll
      for (int db = 0; db < 8; ++db) orow[16 * db] = (bf16_t)f2bf(o[qb][db][r] * rl); }
#undef AISSUE
#undef KPTR
#undef VBASE
#undef WAITV4
#undef WAITV0
}

__device__ __forceinline__ void dft_task(const bf16_t* __restrict__ src, long row0, int rstride, int NTlog, const bf16_t* __restrict__ F, int frow0, int ch,
                                         LAS unsigned char* vl, int lane, f32x16 (&o)[4]) {
  const int r32 = lane & 31, hi = lane >> 5, NT = 1 << NTlog, K = 2 * NT, ntile = K / 64;
  const int vb = (int)(uintptr_t)vl + v_rd_base(lane);
  const int cc = (lane & 15) * 8, key0 = lane >> 4;
#pragma unroll
  for (int d = 0; d < 4; ++d) o[d] = f32x16{};
  u32x4 st[16];
#define DFT_LOAD1(dst, kt_, i) do { const int kg = (kt_) * 64 + 4 * (i) + key0, ri = kg >> NTlog, tt = kg & (NT - 1); \
      dst = *(const u32x4*)(src + (size_t)(row0 + (long)tt * rstride) * 512 + ri * 256 + ch * 128 + cc); } while (0)
#pragma unroll
  for (int i = 0; i < 16; ++i) DFT_LOAD1(st[i], 0, i);
  for (int kt = 0; kt < ntile; ++kt) {
    constexpr int NPF = 6;
    u32x4 na[NPF];
    const bool more = kt + 1 < ntile;
    if (more) {
#pragma unroll
      for (int i = 0; i < NPF; ++i) DFT_LOAD1(na[i], kt + 1, i);
    }
    const bf16_t* Fp = F + (size_t)(frow0 + r32) * K + kt * 64 + 8 * hi;
    const bf16x8 pa0 = *(const bf16x8*)(Fp), pa1 = *(const bf16x8*)(Fp + 16), pa2 = *(const bf16x8*)(Fp + 32), pa3 = *(const bf16x8*)(Fp + 48);
#pragma unroll
    for (int i = 0; i < 16; ++i) *(LAS u32x4*)(vl + v_st(4 * i + key0, cc)) = st[i];
    asm volatile("s_waitcnt lgkmcnt(0)" ::: "memory");
    pv_d0(o, vb, pa0, pa1, pa2, pa3);
    if (more) {
#pragma unroll
      for (int i = 0; i < NPF; ++i) st[i] = na[i];
#pragma unroll
      for (int i = NPF; i < 16; ++i) DFT_LOAD1(st[i], kt + 1, i);
    }
  }
#undef DFT_LOAD1
}
}


#define XB_TMO      128
#define XB_XCNT(j)  (256  + 64 * (j))
#define XB_XSUB(j)  (1280 + 64 * (j))
#define XB_XGEN(j)  (2304 + 64 * (j))
#define XB_TOP      3328
#define XB_TOPGEN   3392
#define XCD_BAR_WORDS 3456
#define XB_SPIN_CAP (1u << 22)
__device__ __forceinline__ unsigned xb_ld(unsigned* p)              { return __hip_atomic_load(p, __ATOMIC_RELAXED, __HIP_MEMORY_SCOPE_AGENT); }
__device__ __forceinline__ unsigned xb_add(unsigned* p, unsigned v) { return __hip_atomic_fetch_add(p, v, __ATOMIC_RELAXED, __HIP_MEMORY_SCOPE_AGENT); }
__device__ __forceinline__ unsigned xb_xcc_id() { return (unsigned)__builtin_amdgcn_s_getreg((3 << 11) | 20) & 0xFu; }
#define XB_SPIN(cond, bar) do { unsigned _sp = 0; while (cond) { __builtin_amdgcn_s_sleep(1); \
    if ((++_sp & 255u) == 0u) { if (xb_ld(&(bar)[XB_TMO])) break; if (_sp > XB_SPIN_CAP) { atomicAdd(&(bar)[XB_TMO], 1u); break; } } } } while (0)
struct XcdBarrier { unsigned* bar; unsigned x; volatile LAS unsigned* st; };
__device__ __forceinline__ XcdBarrier xcd_barrier_post(unsigned* bar, volatile LAS unsigned* st) {
    XcdBarrier b; b.bar = bar; b.x = xb_xcc_id(); b.st = st;
    if (threadIdx.x == 0) (void)xb_add(&bar[XB_XCNT(b.x)], 1u);
    return b;
}
__device__ __forceinline__ void xcd_barrier_complete(unsigned* bar, unsigned x, unsigned& nloc, unsigned& nx) {
    const unsigned G = gridDim.x * gridDim.y * gridDim.z;
    unsigned sum, cnt, mine, sp = 0u;
    for (;;) {
        sum = 0u; cnt = 0u; mine = 0u;
#pragma unroll
        for (unsigned j = 0; j < 16; ++j) { const unsigned c = xb_ld(&bar[XB_XCNT(j)]); sum += c; cnt += (c > 0u) ? 1u : 0u; mine = (j == x) ? c : mine; }
        if (sum == G) break;
        __builtin_amdgcn_s_sleep(1);
        if ((++sp & 255u) == 0u) { if (xb_ld(&bar[XB_TMO])) break; if (sp > XB_SPIN_CAP) { atomicAdd(&bar[XB_TMO], 1u); break; } }
    }
    nloc = mine > 0u ? mine : 1u; nx = cnt > 0u ? cnt : 1u;
}
__device__ __forceinline__ void xcd_barrier(const XcdBarrier& b) {
    asm volatile("s_waitcnt vmcnt(0)" ::: "memory");
    __syncthreads();
    if (threadIdx.x == 0) {
        unsigned* bar = b.bar;
        __builtin_amdgcn_s_waitcnt(0);
        unsigned nloc = b.st[0], nx = b.st[1];
        if (nloc == 0u) { xcd_barrier_complete(bar, b.x, nloc, nx); b.st[0] = nloc; b.st[1] = nx; }
        const unsigned old = xb_add(&bar[XB_XSUB(b.x)], 1u);
        const unsigned gen = old / nloc;
        if (old + 1u == (gen + 1u) * nloc) {
            __builtin_amdgcn_fence(__ATOMIC_RELEASE, "agent");
            asm volatile("s_waitcnt vmcnt(0)" ::: "memory");
            const unsigned og = xb_add(&bar[XB_TOP], 1u);
            const unsigned tg = og / nx;
            if (og + 1u == (tg + 1u) * nx) xb_add(&bar[XB_TOPGEN], 1u);
            else XB_SPIN(xb_ld(&bar[XB_TOPGEN]) == tg, bar);
            __builtin_amdgcn_fence(__ATOMIC_ACQUIRE, "agent");
            xb_add(&bar[XB_XGEN(b.x)], 1u);
            asm volatile("s_waitcnt vmcnt(0)" ::: "memory");
        } else {
            XB_SPIN(xb_ld(&bar[XB_XGEN(b.x)]) == gen, bar);
            __builtin_amdgcn_fence(__ATOMIC_ACQUIRE, "agent");
            asm volatile("s_waitcnt vmcnt(0)" ::: "memory");
        }
    }
    __syncthreads();
}
__device__ __forceinline__ int perm_headdim(int e) { return 32 * (2 * (e >> 6) + ((e & 31) >> 4)) + 8 * (((e & 31) >> 2) & 3) + 4 * ((e >> 5) & 1) + (e & 3); }
template <int MAP>
__device__ __forceinline__ void tr_item(const float* __restrict__ W, int ldw, int ncols, int K, const float* __restrict__ gk, bf16_t* WT, LAS float* scr, int item, int lane) {
    const int nblk = ncols / 32, kb = item / nblk, nb = item % nblk, k0 = 64 * kb, n0 = 32 * nb;
    float tv[32];
#pragma unroll
    for (int i = 0; i < 32; ++i) { const int kk = 2 * i + (lane >> 5); tv[i] = W[(size_t)(k0 + kk) * ldw + n0 + (lane & 31)]; }
#pragma unroll
    for (int i = 0; i < 32; ++i) { const int kk = 2 * i + (lane >> 5); float v = tv[i]; if (gk) v *= gk[k0 + kk]; scr[kk * 33 + (lane & 31)] = v; }
    LDS_WAIT(); asm volatile("" ::: "memory");
    const int c = lane & 7;
#pragma unroll
    for (int j = 0; j < 4; ++j) { const int n = (lane >> 3) + 8 * j; const LAS float* s = scr + (8 * c) * 33 + n;
        u32x4 o; o.x = pk2(s[0 * 33], s[1 * 33]); o.y = pk2(s[2 * 33], s[3 * 33]); o.z = pk2(s[4 * 33], s[5 * 33]); o.w = pk2(s[6 * 33], s[7 * 33]);
        int dn = n0 + n;
        if (MAP == 1) { dn = dn < 1024 ? 512 + (dn & ~127) + perm_headdim(dn & 127) : 512 + dn; }
        *(u32x4*)(WT + (size_t)dn * K + k0 + 8 * c) = o; }
    LDS_WAIT(); asm volatile("" ::: "memory");
}
template <int NR>
__device__ __forceinline__ void rms_rows_to_bf16(const float* const (&xrow)[NR], const float* __restrict__ g, bf16_t* const (&orow)[NR], int lane) {
    const f32x4* gr = (const f32x4*)g + lane;
    f32x4 v[NR][4];
#pragma unroll
    for (int r = 0; r < NR; ++r)
#pragma unroll
        for (int j = 0; j < 4; ++j) v[r][j] = ((const f32x4*)xrow[r] + lane)[64 * j];
#pragma unroll
    for (int r = 0; r < NR; ++r) { float s = 0.f;
#pragma unroll
        for (int j = 0; j < 4; ++j) s += pg8::dot4(v[r][j]);
        const float rstd = rsqrtf(wave_sum(s) * (1.f / DM) + EPS);
        unsigned long long* o8 = (unsigned long long*)orow[r] + lane;
#pragma unroll
        for (int j = 0; j < 4; ++j) { const f32x4 gg = gr[64 * j]; const f32x4 y = v[r][j] * rstd * gg;
            o8[64 * j] = (unsigned long long)pk2(y[0], y[1]) | ((unsigned long long)pk2(y[2], y[3]) << 32); } }
}
__device__ __forceinline__ float f1_val(int rg, int k, int N1) {
    const int w = rg >> 5, rho = rg & 31, j = rho & 3, hi = (rho >> 2) & 1, q = rho >> 3, ri = q & 1, s1 = 16 * w + 8 * (q >> 1) + 4 * hi + j;
    const int rip = k / N1, t1 = k % N1, m = (s1 * t1) % N1; const float a = 2.f * (float)m / (float)N1; const float c = cospif(a), s = sinpif(a);
    return ri == 0 ? (rip == 0 ? c : s) : (rip == 0 ? -s : c);
}
__device__ __forceinline__ float f2_val(int s2, int k, int N2, float inv) {
    const int ri = k / N2, t2 = k % N2, m = (s2 * t2) % N2; const float a = 2.f * (float)m / (float)N2; return (ri == 0 ? cospif(a) : sinpif(a)) * inv;
}

struct Params { const float* in[20]; float* out; unsigned char* ws; };

__global__ void __launch_bounds__(512, 2) mega_fwd(Params p) {
    extern __shared__ __attribute__((aligned(16))) unsigned char lds_raw[];
    cg::grid_group grid = cg::this_grid();
    LAS unsigned char* lds = (LAS unsigned char*)lds_raw;
    LAS unsigned char* elds = lds + ELDS_OFF;
    const int tid = threadIdx.x, lane = tid & 63, wave = __builtin_amdgcn_readfirstlane(tid >> 6);
    const int G = gridDim.x, cb = blockIdx.x, gw = cb * 8 + wave, NGW = G * 8;
    unsigned char* ws = p.ws;
    const float *x_p = p.in[0], *x_s = p.in[1], *mem_p = p.in[2], *mem_s = p.in[3], *g_mix = p.in[4], *w_in = p.in[5], *w_f = p.in[6], *g_q = p.in[7], *g_k = p.in[8],
                *w_out = p.in[9], *g_cross = p.in[10], *g_mem = p.in[11], *w_cq = p.in[12], *w_ckv = p.in[13], *g_cq = p.in[14], *g_ck = p.in[15], *w_co = p.in[16],
                *g_mlp = p.in[17], *w_up = p.in[18], *w_down = p.in[19];
    float* out = p.out;
    if (tid < 8) ((LAS unsigned*)(lds + MISC_OFF))[tid] = 0u;
    __syncthreads();
    const XcdBarrier xbar = xcd_barrier_post((unsigned*)(ws + WS_BAR), (volatile LAS unsigned*)(lds + MISC_OFF));
#define GRID_BAR() xcd_barrier(xbar)
#define WSP(T, off) ((T*)(ws_launder(ws) + (off)))
#define SS2 WSP(float, WS_SS2)
#define SS3 WSP(float, WS_SS3)
#define ROPE WSP(float, WS_ROPE)
#define F1P WSP(bf16_t, WS_F1P)
#define F2P WSP(bf16_t, WS_F2P)
#define F1S WSP(bf16_t, WS_F1S)
#define F2S WSP(bf16_t, WS_F2S)
#define WIN WSP(bf16_t, WS_WIN)
#define WOUT WSP(bf16_t, WS_WOUT)
#define WCQ WSP(bf16_t, WS_WCQ)
#define WCKV WSP(bf16_t, WS_WCKV)
#define WCO WSP(bf16_t, WS_WCO)
#define WUP WSP(bf16_t, WS_WUP)
#define WDN WSP(bf16_t, WS_WDN)
#define MN WSP(bf16_t, WS_MN)
#define KC WSP(bf16_t, WS_KC)
#define VT WSP(bf16_t, WS_VT)
#define XN1 WSP(bf16_t, WS_XN1)
#define PB WSP(bf16_t, WS_PB)
#define TMP WSP(bf16_t, WS_TMP)
#define QB WSP(bf16_t, WS_QB)
#define KB WSP(bf16_t, WS_KB)
#define VB WSP(bf16_t, WS_VB)
#define MIX WSP(bf16_t, WS_MIX)
#define XB2 WSP(bf16_t, WS_XB2)
#define QC WSP(bf16_t, WS_QC)
#define PC WSP(bf16_t, WS_PC)
#define OC WSP(bf16_t, WS_OC)
#define XB3 WSP(bf16_t, WS_XB3)
#define HB WSP(bf16_t, WS_H)


    {
        if (cb < 32) {
            const int g = cb >> 3, ri = (cb >> 2) & 1, kq = cb & 3;
            LAS float* Wf_s = (LAS float*)lds; LAS float* M_s = (LAS float*)(lds + 16384); LAS float* T_s = (LAS float*)(lds + 16384 + 64 * 65 * 4);
            for (int i = tid; i < 4096; i += 512) Wf_s[i] = w_f[g * 4096 + i];
            if (tid < 64) { const float a = (float)tid / 32.f; T_s[tid] = ri == 0 ? cospif(a) * 0.125f : -sinpif(a) * 0.125f; }
            __syncthreads();
            { const int cp = tid >> 3, d0 = (tid & 7) * 8; float accm[8];
#pragma unroll
              for (int d = 0; d < 8; ++d) accm[d] = 0.f;
              for (int c = 0; c < 64; ++c) { const float t = T_s[(c * cp) & 63];
#pragma unroll
                  for (int d = 0; d < 8; ++d) accm[d] += t * Wf_s[c * 64 + d0 + d]; }
#pragma unroll
              for (int d = 0; d < 8; ++d) M_s[cp * 65 + d0 + d] = accm[d]; }
            __syncthreads();
            { const int k = kq * 256 + wave * 32 + (lane & 31), dh = lane >> 5; float wrow[64];
              const f32x4* wp = (const f32x4*)(w_in + (size_t)k * 1536 + g * 64);
#pragma unroll
              for (int i = 0; i < 16; ++i) { const f32x4 t = wp[i]; wrow[4 * i] = t[0]; wrow[4 * i + 1] = t[1]; wrow[4 * i + 2] = t[2]; wrow[4 * i + 3] = t[3]; }
              for (int d = 0; d < 32; ++d) { float a = 0.f;
#pragma unroll
                  for (int c = 0; c < 64; ++c) a += wrow[c] * M_s[c * 65 + 32 * dh + d];
                  WIN[(size_t)(ri * 256 + g * 64 + 32 * dh + d) * 1024 + k] = (bf16_t)f2bf(a); } }
        }
        __syncthreads();
        LAS float* scr = (LAS float*)(lds + wave * 16384);
        constexpr int I_IN = 40 * 16, I_SQ = 32 * 16, I_CKV = 64 * 16, I_UP = 128 * 16, I_DN = 32 * 64;
        constexpr int NITEMS = I_IN + 3 * I_SQ + I_CKV + I_UP + I_DN;
        for (int it = gw; it < NITEMS; it += NGW) {
            int r = it;
            if (r < I_IN) { tr_item<1>(w_in + 256, 1536, 1280, 1024, nullptr, WIN, scr, r, lane); continue; } r -= I_IN;
            if (r < I_SQ) { tr_item<0>(w_out, 1024, 1024, 1024, nullptr, WOUT, scr, r, lane); continue; } r -= I_SQ;
            if (r < I_SQ) { tr_item<0>(w_cq, 1024, 1024, 1024, g_cross, WCQ, scr, r, lane); continue; } r -= I_SQ;
            if (r < I_SQ) { tr_item<0>(w_co, 1024, 1024, 1024, nullptr, WCO, scr, r, lane); continue; } r -= I_SQ;
            if (r < I_CKV) { tr_item<0>(w_ckv, 2048, 2048, 1024, nullptr, WCKV, scr, r, lane); continue; } r -= I_CKV;
            if (r < I_UP) { tr_item<0>(w_up, 4096, 4096, 1024, g_mlp, WUP, scr, r, lane); continue; } r -= I_UP;
            tr_item<0>(w_down, 1024, 1024, 4096, nullptr, WDN, scr, r, lane);
        }
        for (int m = gw; m < TT; m += 4 * NGW) {
            if (m + 3 * NGW < TT) {
                const float* xr[4]; bf16_t* orw[4];
#pragma unroll
                for (int r = 0; r < 4; ++r) { const int mr = m + r * NGW; xr[r] = mr < TP ? x_p + (size_t)mr * DM : x_s + (size_t)(mr - TP) * DM; orw[r] = XN1 + (size_t)mr * DM; }
                rms_rows_to_bf16<4>(xr, g_mix, orw, lane);
            } else {
                for (int mr = m; mr < TT; mr += NGW) { const float* xr[1] = {mr < TP ? x_p + (size_t)mr * DM : x_s + (size_t)(mr - TP) * DM}; bf16_t* orw[1] = {XN1 + (size_t)mr * DM};
                    rms_rows_to_bf16<1>(xr, g_mix, orw, lane); }
            }
        }
        for (int mm = gw; mm < NMEMROWS; mm += NGW) { const float* xr[1] = {mm < 256 ? mem_p + (size_t)mm * DM : mem_s + (size_t)(mm - 256) * DM}; bf16_t* orw[1] = {MN + (size_t)mm * DM};
            rms_rows_to_bf16<1>(xr, g_mem, orw, lane); }
        for (int i = cb * 512 + tid; i < 118784 + 98304; i += G * 512) {
            int r = i;
            if (r < 65536) { F1P[r] = (bf16_t)f2bf(f1_val(r >> 8, r & 255, 128)); continue; } r -= 65536;
            if (r < 32768) { F2P[r] = (bf16_t)f2bf(f2_val(r >> 8, r & 255, 128, 0.0078125f)); continue; } r -= 32768;
            if (r < 4096) { F1S[r] = (bf16_t)f2bf(f1_val(r >> 6, r & 63, 32)); continue; } r -= 4096;
            if (r < 8192) { F2S[r] = (bf16_t)f2bf(f2_val(r >> 7, r & 127, 64, 0.022097086912079608f)); continue; } r -= 8192;
            if (r < 8192) { const int v = r >> 5, j = r & 31; const float inv = 1.0f / powf(10000.f, (float)(2 * j) / 64.f); const float ang = (float)v * inv;
                ROPE[2 * r] = cosf(ang); ROPE[2 * r + 1] = sinf(ang); continue; } r -= 8192;
            SS2[r] = 0.f;
        }
    }
    grid.sync();

    {
        pg8::PolP1 S{(const char*)ws, G, cb};
        pg8::EpiP1 E{PB, QB, KB, VB, KC, VT, g_q, g_k, g_ck, ROPE};
        pg8::gemm_phase(wave, lds, elds, S, E, 1024, 1024, 1024);
    }
    GRID_BAR();

    {
        const int tl = opaque_tid(wave), lane = tl & 63;
        LAS unsigned char* vl = lds + wave * 16384;
        const int r32 = lane & 31, hi = lane >> 5;
        for (int tau = gw; tau < 2048 + 4096; tau += NGW) {
            int ch, w, t2, N2, Slog; long base; const bf16_t* F; int NTlog;
            if (tau < 2048) { ch = tau & 1; w = (tau >> 1) & 7; t2 = tau >> 4; base = 0; N2 = 128; Slog = 14; F = F1P; NTlog = 7; }
            else { const int t = tau - 2048; ch = t & 1; w = (t >> 1) & 1; t2 = (t >> 2) & 63; base = TP + (long)(t >> 8) * SS_LEN; N2 = 64; Slog = 11; F = F1S; NTlog = 5; }
            f32x16 o[4];
            att::dft_task(PB, base + t2, N2, NTlog, F, 32 * w, ch, vl, lane, o);
#pragma unroll
            for (int pp = 0; pp < 2; ++pp)
#pragma unroll
                for (int j = 0; j < 4; ++j) { const int s1 = 16 * w + 8 * pp + 4 * hi + j; const int mm = (s1 * t2) & ((1 << Slog) - 1);
                    const float a = 2.f * (float)mm / (float)(1 << Slog); const float c = cospif(a), s = sinpif(a);
                    bf16_t* dp = TMP + (size_t)(base + (long)s1 * N2 + t2) * 512 + ch * 128 + r32;
#pragma unroll
                    for (int d0 = 0; d0 < 4; ++d0) { const float re = o[d0][8 * pp + j], im = o[d0][8 * pp + 4 + j];
                        dp[d0 * 32] = (bf16_t)f2bf(re * c + im * s); dp[256 + d0 * 32] = (bf16_t)f2bf(im * c - re * s); } }
        }
    }
    GRID_BAR();

    {
        const int tl = opaque_tid(wave), lane = tl & 63;
        LAS unsigned char* vl = lds + wave * 16384;
        const int r32 = lane & 31, hi = lane >> 5;
        for (int it = 0; ; ++it) {
            int tau;
            if (NGW == 2048) { if (gw < 1024) { if (it > 0) break; tau = gw; } else { if (it > 1) break; tau = gw + it * 1024; } }
            else { tau = gw + it * NGW; if (tau >= 1024 + 2048) break; }
            int ch, rb, s1, N1, N2; long base; const bf16_t* F; int NTlog;
            if (tau < 1024) { ch = tau & 1; rb = (tau >> 1) & 3; s1 = tau >> 3; base = 0; N1 = 128; N2 = 128; F = F2P; NTlog = 7; }
            else { const int t = tau - 1024; ch = t & 1; rb = (t >> 1) & 1; s1 = (t >> 2) & 31; base = TP + (long)(t >> 7) * SS_LEN; N1 = 32; N2 = 64; F = F2S; NTlog = 6; }
            f32x16 o[4];
            att::dft_task(TMP, base + (long)s1 * N2, 1, NTlog, F, 32 * rb, ch, vl, lane, o);
#pragma unroll
            for (int r = 0; r < 16; ++r) { const int s2 = 32 * rb + att::crow(r, hi); bf16_t* dp = MIX + (size_t)(base + s1 + (long)N1 * s2) * 1024 + ch * 128 + r32;
#pragma unroll
                for (int d0 = 0; d0 < 4; ++d0) dp[d0 * 32] = (bf16_t)f2bf(o[d0][r]); }
        }
        __syncthreads();
        float gqm = fmaxf(fabsf(g_q[lane]), fabsf(g_q[lane + 64])), gkm = fmaxf(fabsf(g_k[lane]), fabsf(g_k[lane + 64]));
#pragma unroll
        for (int o = 1; o < 64; o <<= 1) { gqm = fmaxf(gqm, __shfl_xor(gqm, o)); gkm = fmaxf(gkm, __shfl_xor(gkm, o)); }
        const float BC = 128.f * 1.02f * gqm * gkm * (att::SCALE * 1.4426950408889634f);
        const bool use_static = BC < 60.f;
        const float negBC = -BC;
        const int nun = (G == 256) ? (cb < 128 ? 2 : 7) : (1152 - cb + G - 1) / G;
        for (int iu = 0; iu < nun; ++iu) {
            int uidx;
            if (G == 256) { const int cc = cb - 128, xk = cc >> 3; uidx = cb < 128 ? cb + 256 * iu : (iu == 0 ? cb : 384 + (2 * (cc & 7) + (xk >> 3)) * 48 + (xk & 7) * 6 + (iu - 1)); }
            else uidx = cb + iu * G;
            long rowbase, kvbase; int h, qb, seq;
            if (uidx < 384) { h = uidx >> 6; qb = uidx & 63; rowbase = 0; kvbase = 0; seq = TP; }
            else { const int v = uidx - 384; const int b = v / 48, rem = v % 48; h = rem >> 3; qb = rem & 7; kvbase = TP + (long)b * SS_LEN; rowbase = kvbase; seq = SS_LEN; }
            const long qrow = rowbase + (long)qb * 256; const int kvh = h / 3;
            if (use_static) att::attn_body16(negBC, QB + (size_t)qrow * 768 + h * 128, KB + (size_t)kvbase * 512 + kvh * 256, KB + (size_t)kvbase * 512 + kvh * 256 + 128,
                                 MIX + (size_t)qrow * 1024 + 256 + h * 128, seq, lds, elds, wave);
            else att::attn_dense_body<false>(0.f, QB + (size_t)qrow * 768 + h * 128, KB + (size_t)kvbase * 512 + kvh * 256, KB + (size_t)kvbase * 512 + kvh * 256 + 128,
                                 MIX + (size_t)qrow * 1024 + 256 + h * 128, seq, lds, elds, wave);
            __syncthreads();
        }
    }
    GRID_BAR();

    {
        pg8::PolSimple S{MIX, WOUT, 192, 4, 1024, 1024, G, cb};
        pg8::EpiResid E{x_p, x_s, out, XB2, SS2, 0};
        pg8::gemm_phase(wave, lds, elds, S, E, 1024, 1024, 1024);
    }
    GRID_BAR();
    {
        pg8::PolSimple S{XB2, WCQ, 192, 4, 1024, 1024, G, cb};
        pg8::EpiCq E{SS2, g_cq, QC};
        pg8::gemm_phase(wave, lds, elds, S, E, 1024, 1024, 1024);
    }
    __syncthreads();
    {
        pg8::PolS S{QC, KC, G, cb};
        pg8::EpiSoftmax E{PC};
        pg8::gemm_phase(wave, lds, elds, S, E, 256, 1024, 1024);
    }
    __syncthreads();
    {
        pg8::PolPV S{PC, VT, G, cb};
        pg8::EpiPlain E{OC, 1024};
        pg8::gemm_phase(wave, lds, elds, S, E, 256, 1024, NMEMROWS);
    }
    GRID_BAR();
    {
        pg8::PolSimple S{OC, WCO, 192, 4, 1024, 1024, G, cb};
        pg8::EpiResid E{out, out + (size_t)TP * DM, out, XB3, SS3, 0};
        pg8::gemm_phase(wave, lds, elds, S, E, 1024, 1024, 1024);
    }
    GRID_BAR();
    for (int ck = 0; ck <= 3; ++ck) {
        if (ck >= 1) {
            pg8::PolSimple S{HB + (size_t)((ck - 1) & 1) * 16384 * 4096, WDN, 64, 4, 4096, 4096, G, cb};
            pg8::EpiResid E{out, out + (size_t)TP * DM, out, nullptr, nullptr, (ck - 1) * 16384};
            pg8::gemm_phase(wave, lds, elds, S, E, 4096, 4096, 4096);
        }
        if (ck < 3) {
            pg8::PolSimple S{XB3 + (size_t)ck * 16384 * DM, WUP, 64, 16, 1024, 1024, G, cb};
            pg8::EpiUp E{SS3, HB + (size_t)(ck & 1) * 16384 * 4096, ck * 16384};
            pg8::gemm_phase(wave, lds, elds, S, E, 1024, 1024, 1024);
            GRID_BAR();
        }
    }
}

#undef WSP
#undef SS2
#undef SS3
#undef ROPE
#undef F1P
#undef F2P
#undef F1S
#undef F2S
#undef WIN
#undef WOUT
#undef WCQ
#undef WCKV
#undef WCO
#undef WUP
#undef WDN
#undef MN
#undef KC
#undef VT
#undef XN1
#undef PB
#undef TMP
#undef QB
#undef KB
#undef VB
#undef MIX
#undef XB2
#undef QC
#undef PC
#undef OC
#undef XB3
#undef HB
extern "C" void kernel_launch(void* const* d_in, const int* in_sizes, int n_in, void* d_out, int out_size, void* d_ws, size_t ws_size, hipStream_t stream) {
    static int grid = 0;
    if (grid == 0) {
        if (n_in != 20 || out_size != TT * DM || ws_size < WS_NEED) { fprintf(stderr, "kernel_launch: unexpected shapes: n_in %d out %d ws %zu\n", n_in, out_size, ws_size); grid = -1; return; }
        int dev = 0, cus = 0, per_cu = 0;
        hipGetDevice(&dev); hipDeviceGetAttribute(&cus, hipDeviceAttributeMultiprocessorCount, dev);
        if (hipFuncSetAttribute((const void*)mega_fwd, hipFuncAttributeMaxDynamicSharedMemorySize, LDS_BYTES) != hipSuccess) { fprintf(stderr, "kernel_launch: hipFuncSetAttribute failed\n"); grid = -1; return; }
        if (hipOccupancyMaxActiveBlocksPerMultiprocessor(&per_cu, (const void*)mega_fwd, 512, LDS_BYTES) != hipSuccess || per_cu < 1) { fprintf(stderr, "kernel_launch: occupancy query failed (%d)\n", per_cu); grid = -1; return; }
        grid = cus;
    }
    if (grid < 0) return;
    if (hipMemsetAsync((char*)d_ws + WS_BAR, 0, BAR_BYTES, stream) != hipSuccess) { fprintf(stderr, "kernel_launch: hipMemsetAsync failed\n"); return; }
    Params p{};
    for (int i = 0; i < 20; ++i) p.in[i] = (const float*)d_in[i];
    p.out = (float*)d_out; p.ws = (unsigned char*)d_ws;
    void* args[] = {&p};
    hipError_t e = hipLaunchCooperativeKernel((const void*)mega_fwd, dim3(grid), dim3(512), args, LDS_BYTES, stream);
    if (e != hipSuccess) fprintf(stderr, "kernel_launch: cooperative launch failed: %s (grid %d)\n", hipGetErrorString(e), grid);
}
```

```cpp
#include <hip/hip_runtime.h>
#include <hip/hip_cooperative_groups.h>
#include <cstdio>
#include <cstdint>
namespace cg = cooperative_groups;

#define LAS __attribute__((address_space(3)))
typedef unsigned short bf16_t;
typedef short bf16x8 __attribute__((ext_vector_type(8)));
typedef short s16x4 __attribute__((ext_vector_type(4)));
typedef float f32x4 __attribute__((ext_vector_type(4)));
typedef float f32x16 __attribute__((ext_vector_type(16)));
typedef unsigned u32x4 __attribute__((ext_vector_type(4)));

constexpr int DM = 1024, TP = 16384, TS = 32768, TT = TP + TS, SS_LEN = 2048, NMEMROWS = 17 * 256;
constexpr int NIN = 1792;
constexpr float EPS = 1e-6f;
constexpr size_t MiB = 1u << 20, KiB = 1024;
constexpr size_t WS_SS2 = 0, WS_SS3 = 196608;
constexpr size_t WS_ROPE = 512 * KiB;
constexpr size_t WS_F1P = 640 * KiB, WS_F2P = 768 * KiB, WS_F1S = 832 * KiB, WS_F2S = 840 * KiB;
constexpr size_t WS_WIN = 1 * MiB, WS_WOUT = WS_WIN + 3584 * KiB, WS_WCQ = WS_WOUT + 2 * MiB, WS_WCKV = WS_WCQ + 2 * MiB,
                 WS_WCO = WS_WCKV + 4 * MiB, WS_WUP = WS_WCO + 2 * MiB, WS_WDN = WS_WUP + 8 * MiB;
constexpr size_t WS_MN = 31 * MiB, WS_KC = WS_MN + 8704 * KiB, WS_VT = WS_KC + 8704 * KiB;
constexpr size_t SLOT_A = 64 * MiB, SLOT_B = 160 * MiB, SLOT_C = 256 * MiB, SLOT_D = 352 * MiB, SLOT_E = 448 * MiB;
constexpr size_t WS_XN1 = SLOT_A, WS_PB = SLOT_B, WS_TMP = SLOT_B + 48 * MiB, WS_QB = SLOT_C, WS_KB = SLOT_E  , WS_VB = SLOT_E;
constexpr size_t WS_MIX = SLOT_A, WS_XB2 = SLOT_B, WS_QC = SLOT_C, WS_PC = SLOT_D, WS_OC = SLOT_A, WS_XB3 = SLOT_B, WS_H = SLOT_C;
constexpr size_t WS_BAR = 896 * KiB, BAR_BYTES = 16 * KiB;
constexpr size_t WS_NEED = 512 * MiB;
constexpr int LDS_BYTES = 147456, ELDS_OFF = 131072, MISC_OFF = ELDS_OFF + 12288;

__device__ __forceinline__ unsigned cvt_pk_bf16(float lo, float hi) { unsigned r; asm volatile("v_cvt_pk_bf16_f32 %0, %1, %2" : "=v"(r) : "v"(lo), "v"(hi)); return r; }
__device__ __forceinline__ unsigned f2bf(float f) { unsigned u = __builtin_bit_cast(unsigned, f); return (u + 0x7fffu + ((u >> 16) & 1u)) >> 16; }
__device__ __forceinline__ unsigned pk2(float lo, float hi) { return f2bf(lo) | (f2bf(hi) << 16); }
__device__ __forceinline__ float wave_sum(float v) {
#pragma unroll
    for (int o = 1; o < 64; o <<= 1) v += __shfl_xor(v, o);
    return v;
}
__device__ __forceinline__ int opaque_tid(int wave) { int t; asm volatile("v_mbcnt_lo_u32_b32 %0, -1, 0\n\tv_mbcnt_hi_u32_b32 %0, -1, %0\n\tv_or_b32 %0, %1, %0" : "=&v"(t) : "s"(wave << 6)); return t; }
__device__ __forceinline__ unsigned char* ws_launder(unsigned char* p) { asm volatile("" : "+s"(p)); return p; }
#define LDS_WAIT() asm volatile("s_waitcnt lgkmcnt(0)" ::: "memory")
#define RAW_BAR() do { asm volatile("s_waitcnt lgkmcnt(0)" ::: "memory"); __builtin_amdgcn_s_barrier(); asm volatile("" ::: "memory"); } while (0)

namespace pg8 {
constexpr int BM = 256, BK = 64, HALF = 128, HTB = HALF * BK * 2, STAGE_BYTES = 8 * HTB, NXCD = 8, WGM = 8;
__host__ __device__ __forceinline__ int lds_byte(int r, int c) { const int st = (r >> 4) * 2 + (c >> 5), rr = r & 15, cc = c & 31, ob = rr * 64 + cc * 2; return st * 1024 + (ob ^ (((ob >> 9) & 1) << 5)); }
__host__ __device__ __forceinline__ void stage_rc(int b, int& R, int& C) { const int st = b / 1024, sb = b % 1024, swz = sb ^ (((sb >> 9) & 1) << 5); R = (st >> 1) * 16 + swz / 64; C = (st & 1) * 32 + (swz % 64) / 2; }
__host__ __device__ __forceinline__ int perm32(int rho) { const int n = rho >> 4, i = rho & 15; return 8 * (i >> 2) + 4 * n + (i & 3); }

struct Unit { int pm, pn, gid; };
__device__ __forceinline__ void map_tile(int wgid, int nM, int nN, int& pm, int& pn) {
    const int nwg = nM * nN;
    { const int q = nwg / NXCD, r = nwg % NXCD, xcd = wgid % NXCD, off = wgid / NXCD; wgid = (xcd < r ? xcd * (q + 1) : r * (q + 1) + (xcd - r) * q) + off; }
    const int nig = WGM * nN, gid = wgid / nig, fm = gid * WGM, gsz = (nM - fm) < WGM ? (nM - fm) : WGM;
    pm = fm + ((wgid % nig) % gsz); pn = (wgid % nig) / gsz;
}
template <class Epi, class Pol>
__device__ __forceinline__ void gemm_phase(const int wave_id, LAS unsigned char* lds, LAS unsigned char* elds, const Pol& S, const Epi& E, const int K, const int lda, const int ldb) {
    const int tid = opaque_tid(wave_id), wid = __builtin_amdgcn_readfirstlane(tid >> 6), lane = tid & 63, wr = wid >> 2, wc = wid & 3, fr = lane & 15, fq = lane >> 4;
    int nt = K / BK; asm volatile("" : "+s"(nt));
    unsigned voffA[2], voffB[2];
#pragma unroll
    for (int i = 0; i < 2; ++i) { int R, C; stage_rc(tid * 16 + i * 8192, R, C); const int Rb = (R & ~31) + perm32(R & 31);
        voffA[i] = (unsigned)(R * lda + C) * 2u; voffB[i] = (unsigned)(Rb * ldb + C) * 2u; }
    const size_t kstep = (size_t)(BK * 2);
    const size_t hA = (size_t)HALF * lda * 2, hB = (size_t)HALF * ldb * 2;
    const unsigned ldsw = (unsigned)wid * 1024u;
    const int aoff = lds_byte(wr * 64 + fr, fq * 8), boff = lds_byte(wc * 32 + fr, fq * 8);
#define PG8_SA(b, h) (((b) * 2 + (h)) * HTB)
#define PG8_SB(b, h) ((4 + (b) * 2 + (h)) * HTB)
#define PG8_STAGE(bufoff, gbase, voff) do { _Pragma("unroll") for (int _i = 0; _i < 2; ++_i) \
        __builtin_amdgcn_global_load_lds((const unsigned*)((const char*)(gbase) + (voff)[_i]), (LAS unsigned*)(lds + (bufoff) + ldsw + _i * 8192), 16, 0, 0); } while (0)
#define PG8_LDA(dst, b, h) do { _Pragma("unroll") for (int m = 0; m < 4; ++m) _Pragma("unroll") for (int k = 0; k < 2; ++k) dst[m][k] = *(const LAS bf16x8*)(lds + PG8_SA(b, h) + aoff + m * 2048 + k * 1024); } while (0)
#define PG8_LDB(dst, b, h) do { _Pragma("unroll") for (int n = 0; n < 2; ++n) _Pragma("unroll") for (int k = 0; k < 2; ++k) dst[n][k] = *(const LAS bf16x8*)(lds + PG8_SB(b, h) + boff + n * 2048 + k * 1024); } while (0)
#define PG8_MMA(ai, bj, At, Bt) do { __builtin_amdgcn_s_setprio(1); _Pragma("unroll") for (int m = 0; m < 4; ++m) _Pragma("unroll") for (int n = 0; n < 2; ++n) _Pragma("unroll") for (int k = 0; k < 2; ++k) \
        acc[ai][bj][m][n] = __builtin_amdgcn_mfma_f32_16x16x32_bf16(Bt[n][k], At[m][k], acc[ai][bj][m][n], 0, 0, 0); __builtin_amdgcn_s_setprio(0); } while (0)
#define PG8_WAIT_V(n) asm volatile("s_waitcnt vmcnt(" #n ")" ::: "memory")
#define PG8_WAIT_L(n) asm volatile("s_waitcnt lgkmcnt(" #n ")" ::: "memory")
#define PG8_BAR __builtin_amdgcn_s_barrier()
#define PG8_SCHED __builtin_amdgcn_sched_barrier(0)
    Unit cur, nxt; int ui = 0;
    if (!S.next(0, cur)) return;
    f32x4 acc[2][2][4][2];
#pragma unroll
    for (int a = 0; a < 2; ++a)
#pragma unroll
        for (int b = 0; b < 2; ++b)
#pragma unroll
            for (int m = 0; m < 4; ++m)
#pragma unroll
                for (int n = 0; n < 2; ++n) acc[a][b][m][n] = (f32x4){0.f, 0.f, 0.f, 0.f};
    bf16x8 At[4][2], B0[2][2], B1[2][2];
    const char* cA = S.a_base(cur); const char* cB = S.b_base(cur);
    PG8_STAGE(PG8_SB(0, 0), cB, voffB); PG8_STAGE(PG8_SB(0, 1), cB + hB, voffB); PG8_STAGE(PG8_SA(0, 0), cA, voffA); PG8_STAGE(PG8_SA(0, 1), cA + hA, voffA);
    if (wr == 1) PG8_BAR;
    PG8_WAIT_V(2); PG8_BAR;
    PG8_STAGE(PG8_SB(1, 0), cB + kstep, voffB); PG8_STAGE(PG8_SA(1, 0), cA + kstep, voffA); PG8_STAGE(PG8_SB(1, 1), cB + hB + kstep, voffB);
    PG8_WAIT_V(6); PG8_BAR;
    for (;;) {
        const bool has_next = S.next(ui + 1, nxt);
        const char* nA = has_next ? S.a_base(nxt) : cA; const char* nB = has_next ? S.b_base(nxt) : cB;
        for (int t = 0; t < nt; t += 2) {
            const bool last = (t == nt - 2);
            const char* a1 = cA + (size_t)(t + 1) * kstep;
            const char* a2 = last ? nA : cA + (size_t)(t + 2) * kstep; const char* b2 = last ? nB : cB + (size_t)(t + 2) * kstep;
            const char* a3 = a2 + kstep; const char* b3 = b2 + kstep;
            PG8_LDB(B0, 0, 0); PG8_LDB(B1, 0, 1); PG8_SCHED; PG8_LDA(At, 0, 0); PG8_STAGE(PG8_SA(1, 1), a1 + hA, voffA);
            PG8_WAIT_V(8); PG8_WAIT_L(0); PG8_BAR; PG8_MMA(0, 0, At, B0); PG8_MMA(0, 1, At, B1); PG8_BAR; PG8_SCHED;
            PG8_LDA(At, 0, 1); PG8_STAGE(PG8_SB(0, 0), b2, voffB); PG8_STAGE(PG8_SB(0, 1), b2 + hB, voffB); PG8_STAGE(PG8_SA(0, 0), a2, voffA);
            PG8_WAIT_V(8); PG8_WAIT_L(0); PG8_BAR; PG8_MMA(1, 0, At, B0); PG8_MMA(1, 1, At, B1); PG8_BAR; PG8_SCHED;
            PG8_LDB(B0, 1, 0); PG8_LDB(B1, 1, 1); PG8_SCHED; PG8_LDA(At, 1, 0); PG8_STAGE(PG8_SA(0, 1), a2 + hA, voffA);
            PG8_WAIT_V(8); PG8_WAIT_L(0); PG8_BAR; PG8_MMA(0, 0, At, B0); PG8_MMA(0, 1, At, B1); PG8_BAR; PG8_SCHED;
            PG8_LDA(At, 1, 1); PG8_STAGE(PG8_SB(1, 0), b3, voffB); PG8_STAGE(PG8_SB(1, 1), b3 + hB, voffB); PG8_STAGE(PG8_SA(1, 0), a3, voffA);
            PG8_WAIT_V(8); PG8_WAIT_L(0); PG8_BAR; PG8_MMA(1, 0, At, B0); PG8_MMA(1, 1, At, B1); PG8_BAR; PG8_SCHED;
        }
        if (wr == 0) PG8_BAR;
        { int fr2 = fr, fq2 = fq; asm volatile("" : "+v"(fr2), "+v"(fq2));
          E(acc, cur, wr, wc, fr2, fq2, elds); }
        if (!has_next) break;
#pragma unroll
        for (int a = 0; a < 2; ++a)
#pragma unroll
            for (int b = 0; b < 2; ++b)
#pragma unroll
                for (int m = 0; m < 4; ++m)
#pragma unroll
                    for (int n = 0; n < 2; ++n) acc[a][b][m][n] = (f32x4){0.f, 0.f, 0.f, 0.f};
        cur = nxt; cA = nA; cB = nB; ++ui;
        if (wr == 1) PG8_BAR;
    }
    PG8_WAIT_V(0);
    PG8_BAR;
#undef PG8_SA
#undef PG8_SB
#undef PG8_STAGE
#undef PG8_LDA
#undef PG8_LDB
#undef PG8_MMA
#undef PG8_WAIT_V
#undef PG8_WAIT_L
#undef PG8_BAR
#undef PG8_SCHED
}

__device__ __forceinline__ int batch_of_pm(int pm) { return pm < 64 ? 0 : 1 + ((pm - 64) >> 3); }
struct PolSimple {
    const bf16_t* A; const bf16_t* Bt; int nM, nN, lda, ldb, G, c;
    __device__ __forceinline__ bool next(int i, Unit& u) const { const long L = (long)i * G + c; if (L >= (long)nM * nN) return false; map_tile((int)L, nM, nN, u.pm, u.pn); u.gid = 0; return true; }
    __device__ __forceinline__ const char* a_base(const Unit& u) const { return (const char*)(A + (size_t)u.pm * 256 * lda); }
    __device__ __forceinline__ const char* b_base(const Unit& u) const { return (const char*)(Bt + (size_t)u.pn * 256 * ldb); }
};
struct PolP1 {
    const char* ws; int G, c;
    __device__ __forceinline__ bool next(int i, Unit& u) const {
        long L = (long)i * G + c;
        if (L < 1344) { map_tile((int)L, 192, 7, u.pm, u.pn); u.gid = 0; return true; } L -= 1344;
        if (L < 68) { map_tile((int)L, 17, 4, u.pm, u.pn); u.gid = 1; return true; } L -= 68;
        if (L < 68) { map_tile((int)L, 4, 17, u.pm, u.pn); u.gid = 2; return true; }
        return false;
    }
    __device__ __forceinline__ const char* a_base(const Unit& u) const {
        const size_t off = u.gid == 0 ? WS_XN1 : (u.gid == 1 ? WS_MN : WS_WCKV + (size_t)1024 * 1024 * 2); return ws + off + (size_t)u.pm * 256 * 1024 * 2; }
    __device__ __forceinline__ const char* b_base(const Unit& u) const {
        const size_t off = u.gid == 0 ? WS_WIN : (u.gid == 1 ? WS_WCKV : WS_MN); return ws + off + (size_t)u.pn * 256 * 1024 * 2; }
};
struct PolS {
    const bf16_t* QC; const bf16_t* KC; int G, c;
    __device__ __forceinline__ bool next(int i, Unit& u) const { const long L = (long)i * G + c; if (L >= 768) return false; map_tile((int)L, 192, 4, u.pm, u.pn); u.gid = 0; return true; }
    __device__ __forceinline__ const char* a_base(const Unit& u) const { return (const char*)(QC + (size_t)u.pm * 256 * 1024 + u.pn * 256); }
    __device__ __forceinline__ const char* b_base(const Unit& u) const { return (const char*)(KC + (size_t)batch_of_pm(u.pm) * 256 * 1024 + u.pn * 256); }
};
struct PolPV {
    const bf16_t* PC; const bf16_t* VT; int G, c;
    __device__ __forceinline__ bool next(int i, Unit& u) const { const long L = (long)i * G + c; if (L >= 768) return false; map_tile((int)L, 192, 4, u.pm, u.pn); u.gid = 0; return true; }
    __device__ __forceinline__ const char* a_base(const Unit& u) const { return (const char*)(PC + (size_t)u.pm * 256 * 1024 + u.pn * 256); }
    __device__ __forceinline__ const char* b_base(const Unit& u) const { return (const char*)(VT + (size_t)u.pn * 256 * NMEMROWS + batch_of_pm(u.pm) * 256); }
};

typedef f32x4 Acc[2][2][4][2];
__device__ __forceinline__ float dot4(f32x4 x) { return (x[0] * x[0] + x[1] * x[1]) + (x[2] * x[2] + x[3] * x[3]); }
__device__ __forceinline__ float sum4(f32x4 x) { return (x[0] + x[1]) + (x[2] + x[3]); }
__device__ __forceinline__ void st_bf16x8(bf16_t* p, f32x4 v0, f32x4 v1) {
    u32x4 w; w.x = cvt_pk_bf16(v0[0], v0[1]); w.y = cvt_pk_bf16(v0[2], v0[3]); w.z = cvt_pk_bf16(v1[0], v1[1]); w.w = cvt_pk_bf16(v1[2], v1[3]); *(u32x4*)p = w; }
__device__ __forceinline__ void st_bf16x8_q4(bf16_t* p, f32x4 v0, f32x4 v1) {
    u32x4 w; w.x = cvt_pk_bf16(v0[0], v0[1]); w.y = cvt_pk_bf16(v0[2], v0[3]); w.z = cvt_pk_bf16(v1[0], v1[1]); w.w = cvt_pk_bf16(v1[2], v1[3]);
    w = (w + 0x00080008u) & 0xFFF0FFF0u; *(u32x4*)p = w; }
template <bool Q4 = false>
__device__ __forceinline__ void epi_plain(const Acc& acc, int row0, int wr, int wc, int fr, int fq, bf16_t* dst, size_t ldd, int dcol0, int bjs = 128) {
#pragma unroll
    for (int ai = 0; ai < 2; ++ai)
#pragma unroll
        for (int m = 0; m < 4; ++m) { bf16_t* rp = dst + (size_t)(row0 + ai * 128 + wr * 64 + m * 16 + fr) * ldd + dcol0 + wc * 32 + 8 * fq;
#pragma unroll
            for (int bj = 0; bj < 2; ++bj) { if (Q4) st_bf16x8_q4(rp + bj * bjs, acc[ai][bj][m][0], acc[ai][bj][m][1]); else st_bf16x8(rp + bj * bjs, acc[ai][bj][m][0], acc[ai][bj][m][1]); } }
}
template <int MODE>
__device__ __forceinline__ void epi_rowred256(Acc& acc, int row0, int wr, int wc, int fr, int fq, LAS unsigned char* el,
                                              const float* rs, const float* g, float extra, bf16_t* dst, size_t ldd, int dcol0) {
    LAS float* P = (LAS float*)el;
    float red[2][4];
#pragma unroll
    for (int ai = 0; ai < 2; ++ai)
#pragma unroll
        for (int m = 0; m < 4; ++m) {
            float pre = 1.f; if (MODE == 0 && rs) pre = rsqrtf(rs[row0 + ai * 128 + wr * 64 + m * 16 + fr] * (1.f / 1024.f) + EPS);
            float s = 0.f;
#pragma unroll
            for (int bj = 0; bj < 2; ++bj)
#pragma unroll
                for (int n = 0; n < 2; ++n) { f32x4 x = acc[ai][bj][m][n];
                    if (MODE == 0) { x = x * pre; s += dot4(x); } else { x[0] = __expf(x[0]); x[1] = __expf(x[1]); x[2] = __expf(x[2]); x[3] = __expf(x[3]); s += sum4(x); }
                    acc[ai][bj][m][n] = x; }
            s += __shfl_xor(s, 16); s += __shfl_xor(s, 32);
            red[ai][m] = s;
        }
    if (fq == 0) {
#pragma unroll
        for (int ai = 0; ai < 2; ++ai)
#pragma unroll
            for (int m = 0; m < 4; ++m) P[(ai * 128 + wr * 64 + m * 16 + fr) * 4 + wc] = red[ai][m];
    }
    RAW_BAR();
#pragma unroll
    for (int ai = 0; ai < 2; ++ai)
#pragma unroll
        for (int m = 0; m < 4; ++m) { const int rl = ai * 128 + wr * 64 + m * 16 + fr;
            const f32x4 t = *(const LAS f32x4*)&P[rl * 4]; const float tot = (t[0] + t[1]) + (t[2] + t[3]);
            const float sc = MODE == 0 ? rsqrtf(tot * (1.f / 256.f) + EPS) * extra : 1.f / tot;
            bf16_t* rp = dst + (size_t)(row0 + rl) * ldd + dcol0 + wc * 32 + 8 * fq;
#pragma unroll
            for (int bj = 0; bj < 2; ++bj) { f32x4 v0 = acc[ai][bj][m][0] * sc, v1 = acc[ai][bj][m][1] * sc;
                if (MODE == 0) { const float* gp = g + bj * 128 + wc * 32 + 8 * fq; v0 = v0 * *(const f32x4*)gp; v1 = v1 * *(const f32x4*)(gp + 4); }
                st_bf16x8(rp + bj * 128, v0, v1); } }
}

struct EpiP1 {
    bf16_t *PB, *QB, *KB, *VB, *KC, *VT; const float *g_q, *g_k, *g_ck, *rope;
    __device__ __forceinline__ void operator()(Acc& acc, const Unit& u, int wr, int wc, int fr, int fq, LAS unsigned char* el) const {
        const int row0 = u.pm * 256;
        if (u.gid == 1) { epi_rowred256<0>(acc, row0, wr, wc, fr, fq, el, nullptr, g_ck, 0.0625f, KC, 1024, u.pn * 256); return; }
        if (u.gid == 2) { epi_plain(acc, row0, wr, wc, fr, fq, VT, NMEMROWS, u.pn * 256); return; }
        if (u.pn < 2) { epi_plain(acc, row0, wr, wc, fr, fq, PB, 512, u.pn * 256); return; }
        if (u.pn == 6) { epi_plain<true>(acc, row0, wr, wc, fr, fq, KB, 512, 128, 256); return; }
        const bool isk = (u.pn == 5);
        const float* gain = isk ? g_k : g_q; bf16_t* dst = isk ? KB : QB; const size_t ldd = isk ? 512 : 768; const int hcol0 = isk ? 0 : (u.pn - 2) * 256; const int bjs = isk ? 256 : 128;
        LAS float* P = (LAS float*)el;
#pragma unroll
        for (int ai = 0; ai < 2; ++ai)
#pragma unroll
            for (int m = 0; m < 4; ++m)
#pragma unroll
                for (int bj = 0; bj < 2; ++bj) { float s = dot4(acc[ai][bj][m][0]) + dot4(acc[ai][bj][m][1]);
                    s += __shfl_xor(s, 16); s += __shfl_xor(s, 32);
                    if (fq == 0) P[((ai * 128 + wr * 64 + m * 16 + fr) * 2 + bj) * 4 + wc] = s; }
        RAW_BAR();
        const int blk = wc >> 1, j0 = 16 * (wc & 1) + 4 * fq;
        const f32x4 ga = *(const f32x4*)(gain + 64 * blk + j0), gb = *(const f32x4*)(gain + 64 * blk + 32 + j0);
#pragma unroll
        for (int ai = 0; ai < 2; ++ai)
#pragma unroll
            for (int m = 0; m < 4; ++m) { const int rl = ai * 128 + wr * 64 + m * 16 + fr, row = row0 + rl;
                const int pos = row < TP ? row : ((row - TP) & (SS_LEN - 1)); const int v = blk == 0 ? (pos >> 6) : (pos & 63);
                const float* rp = rope + (size_t)(v * 32 + j0) * 2; const f32x4 cs0 = *(const f32x4*)rp, cs1 = *(const f32x4*)(rp + 4);
                const f32x4 cc = (f32x4){cs0[0], cs0[2], cs1[0], cs1[2]}, sn = (f32x4){cs0[1], cs0[3], cs1[1], cs1[3]};
#pragma unroll
                for (int bj = 0; bj < 2; ++bj) { const f32x4 t = *(const LAS f32x4*)&P[(rl * 2 + bj) * 4];
                    const float rstd = rsqrtf(((t[0] + t[1]) + (t[2] + t[3])) * (1.f / 128.f) + EPS);
                    const f32x4 a = acc[ai][bj][m][0] * rstd * ga, b = acc[ai][bj][m][1] * rstd * gb;
                    st_bf16x8_q4(dst + (size_t)row * ldd + hcol0 + bj * bjs + wc * 32 + 8 * fq, a * cc - b * sn, b * cc + a * sn); } }
    }
};
struct EpiResid {
    const float* base0; const float* base1; float* out; bf16_t* xb; float* ss; int row_off;
    __device__ __forceinline__ void operator()(Acc& acc, const Unit& u, int wr, int wc, int fr, int fq, LAS unsigned char* el) const {
#pragma unroll
        for (int ai = 0; ai < 2; ++ai)
#pragma unroll
            for (int m = 0; m < 4; ++m) { const int row = row_off + u.pm * 256 + ai * 128 + wr * 64 + m * 16 + fr;
                const float* bp = row < TP ? base0 + (size_t)row * DM : base1 + (size_t)(row - TP) * DM; float s = 0.f;
#pragma unroll
                for (int bj = 0; bj < 2; ++bj) { const int col = u.pn * 256 + bj * 128 + wc * 32 + 8 * fq;
                    const f32x4 o0 = *(const f32x4*)(bp + col) + acc[ai][bj][m][0], o1 = *(const f32x4*)(bp + col + 4) + acc[ai][bj][m][1];
                    float* op = out + (size_t)row * DM + col; *(f32x4*)op = o0; *(f32x4*)(op + 4) = o1;
                    if (xb) { st_bf16x8(xb + (size_t)row * DM + col, o0, o1); s += dot4(o0) + dot4(o1); } }
                if (ss) { s += __shfl_xor(s, 16); s += __shfl_xor(s, 32); if (fq == 0) atomicAdd(ss + row, s); } }
    }
};
struct EpiCq { const float* ss2; const float* g_cq; bf16_t* QC;
    __device__ __forceinline__ void operator()(Acc& acc, const Unit& u, int wr, int wc, int fr, int fq, LAS unsigned char* el) const {
        epi_rowred256<0>(acc, u.pm * 256, wr, wc, fr, fq, el, ss2, g_cq, 1.f, QC, 1024, u.pn * 256); } };
struct EpiSoftmax { bf16_t* PC;
    __device__ __forceinline__ void operator()(Acc& acc, const Unit& u, int wr, int wc, int fr, int fq, LAS unsigned char* el) const {
        epi_rowred256<1>(acc, u.pm * 256, wr, wc, fr, fq, el, nullptr, nullptr, 1.f, PC, 1024, u.pn * 256); } };
struct EpiPlain { bf16_t* O; size_t ldd;
    __device__ __forceinline__ void operator()(Acc& acc, const Unit& u, int wr, int wc, int fr, int fq, LAS unsigned char* el) const {
        epi_plain(acc, u.pm * 256, wr, wc, fr, fq, O, ldd, u.pn * 256); } };
struct EpiUp { const float* ss3; bf16_t* H; int row_off;
    __device__ __forceinline__ void operator()(Acc& acc, const Unit& u, int wr, int wc, int fr, int fq, LAS unsigned char* el) const {
#pragma unroll
        for (int ai = 0; ai < 2; ++ai)
#pragma unroll
            for (int m = 0; m < 4; ++m) { const int rl = u.pm * 256 + ai * 128 + wr * 64 + m * 16 + fr;
                const float rstd = rsqrtf(ss3[row_off + rl] * (1.f / 1024.f) + EPS);
                bf16_t* rp = H + (size_t)rl * 4096 + u.pn * 256 + wc * 32 + 8 * fq;
#pragma unroll
                for (int bj = 0; bj < 2; ++bj) { f32x4 v0 = acc[ai][bj][m][0] * rstd, v1 = acc[ai][bj][m][1] * rstd;
#pragma unroll
                    for (int i = 0; i < 4; ++i) { const float a = fmaxf(v0[i], 0.f), b = fmaxf(v1[i], 0.f); v0[i] = a * a; v1[i] = b * b; }
                    st_bf16x8(rp + bj * 128, v0, v1); } }
    }
};
}

namespace att {
constexpr int D = 128, NW = 8, QBLK = 32, KVBLK = 64;
constexpr float SCALE = 0.088388347648318440f;
constexpr float THR = 8.f;
constexpr int LDQ = 768, LDK = 512, LDO = 1024;
constexpr size_t SHM_V = KVBLK * D * 2, SHM_K = KVBLK * D * 2, SHM_ATTN = 2 * SHM_V + 2 * SHM_K + NW * 64 * 4;
#define KSWZ(row, colB) ((row) * 256 + ((colB) ^ (((row) & 7) << 4)))
#define SBAR() __builtin_amdgcn_sched_barrier(0)
__device__ __forceinline__ int crow(int r, int hi) { return (r & 3) + 8 * (r >> 2) + 4 * hi; }
__device__ __forceinline__ unsigned cvtpk(float lo, float hi) { unsigned r; asm volatile("v_cvt_pk_bf16_f32 %0, %1, %2" : "=v"(r) : "v"(lo), "v"(hi)); return r; }
template <bool ST>
__device__ __forceinline__ void partialSM(f32x16& p0, f32x16& p1, float& m_reg, float& mn, float& alpha, float negBC) {
  constexpr float C = SCALE * 1.4426950408889634f;
  float mnC;
  if constexpr (ST) { mn = 0.f; alpha = 1.f; mnC = negBC; }
  else {
  float pmax = p0[0]; for (int r = 1; r < 16; ++r) pmax = fmaxf(pmax, p0[r]); for (int r = 0; r < 16; ++r) pmax = fmaxf(pmax, p1[r]);
  { auto rr = __builtin_amdgcn_permlane32_swap(__float_as_uint(pmax), __float_as_uint(pmax), false, false);
    pmax = fmaxf(__uint_as_float(rr[0]), __uint_as_float(rr[1])); }
  if (__builtin_expect(__all(pmax - m_reg <= THR / SCALE), 1)) { mn = m_reg; alpha = 1.f; }
  else { mn = fmaxf(m_reg, pmax); alpha = __builtin_amdgcn_exp2f((m_reg - mn) * C); m_reg = mn; }
  mnC = -mn * C;
  }
  for (int r = 0; r < 16; ++r) p0[r] = fmaf(p0[r], C, mnC); for (int r = 0; r < 16; ++r) p1[r] = fmaf(p1[r], C, mnC);
  for (int r = 0; r < 16; ++r) p0[r] = __builtin_amdgcn_exp2f(p0[r]);
}
__device__ __forceinline__ void finishSM(f32x16& p0, f32x16& p1, float alpha, float& l_reg, bf16x8& pa0, bf16x8& pa1, bf16x8& pa2, bf16x8& pa3) {
  for (int r = 0; r < 16; ++r) p1[r] = __builtin_amdgcn_exp2f(p1[r]);
  float ps = 0; for (int r = 0; r < 16; ++r) ps += p0[r]; for (int r = 0; r < 16; ++r) ps += p1[r];
  { auto rr = __builtin_amdgcn_permlane32_swap(__float_as_uint(ps), __float_as_uint(ps), false, false);
    ps = __uint_as_float(rr[0]) + __uint_as_float(rr[1]); }
  l_reg = l_reg * alpha + ps;
#define PK4(P, BASE, OUT) do { unsigned a0 = cvtpk(P[BASE + 0], P[BASE + 1]), a1 = cvtpk(P[BASE + 2], P[BASE + 3]);   \
    unsigned b0 = cvtpk(P[BASE + 4], P[BASE + 5]), b1 = cvtpk(P[BASE + 6], P[BASE + 7]);                              \
    auto r0 = __builtin_amdgcn_permlane32_swap(a0, b0, false, false); auto r1 = __builtin_amdgcn_permlane32_swap(a1, b1, false, false); \
    u32x4 w = {r0[0], r1[0], r0[1], r1[1]}; OUT = *reinterpret_cast<bf16x8*>(&w); } while (0)
  PK4(p0, 0, pa0); PK4(p0, 8, pa1); PK4(p1, 0, pa2); PK4(p1, 8, pa3);
#undef PK4
}
__device__ __forceinline__ void qkt(f32x16& p0, f32x16& p1, const LAS unsigned char* Ks, const bf16x8* qr, int r32, int hi) {
  p0 = f32x16{}; p1 = f32x16{};
  for (int d0 = 0; d0 < 8; ++d0) { int cb = (d0 * 16 + hi * 8) * 2;
    bf16x8 b0 = *reinterpret_cast<const LAS bf16x8*>(Ks + KSWZ(r32, cb));
    bf16x8 b1 = *reinterpret_cast<const LAS bf16x8*>(Ks + KSWZ(32 + r32, cb));
    p0 = __builtin_amdgcn_mfma_f32_32x32x16_bf16(b0, qr[d0], p0, 0, 0, 0);
    p1 = __builtin_amdgcn_mfma_f32_32x32x16_bf16(b1, qr[d0], p1, 0, 0, 0); }
}
__device__ __forceinline__ int v_st(int k, int c) { const int kk = (k & ~0xC) | ((k & 4) << 1) | ((k & 8) >> 1); return ((kk >> 3) * 4 + (c >> 5)) * 512 + ((kk & 7) * 32 + (c & 31)) * 2; }
__device__ __forceinline__ int v_rd_base(int lane) { return ((lane & 3) << 3) | (((lane >> 2) & 3) << 6) | (((lane >> 4) & 1) << 5) | (((lane >> 5) & 1) << 8); }
constexpr int v_rd_off(int d0, int ks, int half) { return d0 * 512 + ks * 4096 + half * 2048; }
template <int OFF> __device__ __forceinline__ s16x4 tr_read(int vb) {
  s16x4 r; asm volatile("ds_read_b64_tr_b16 %0, %1 offset:%2" : "=&v"(r) : "v"(vb), "i"(OFF) : "memory"); return r;
}
template <int D0> __device__ __forceinline__ void pv_one(f32x16& od, int vb, bf16x8 pa0, bf16x8 pa1, bf16x8 pa2, bf16x8 pa3) {
  const s16x4 l0 = tr_read<v_rd_off(D0, 0, 0)>(vb), h0 = tr_read<v_rd_off(D0, 0, 1)>(vb), l1 = tr_read<v_rd_off(D0, 1, 0)>(vb), h1 = tr_read<v_rd_off(D0, 1, 1)>(vb);
  const s16x4 l2 = tr_read<v_rd_off(D0, 2, 0)>(vb), h2 = tr_read<v_rd_off(D0, 2, 1)>(vb), l3 = tr_read<v_rd_off(D0, 3, 0)>(vb), h3 = tr_read<v_rd_off(D0, 3, 1)>(vb);
  asm volatile("s_waitcnt lgkmcnt(0)" ::: "memory"); SBAR();
#define PK(L, H) (bf16x8){L[0], L[1], L[2], L[3], H[0], H[1], H[2], H[3]}
  od = __builtin_amdgcn_mfma_f32_32x32x16_bf16(pa0, PK(l0, h0), od, 0, 0, 0);
  od = __builtin_amdgcn_mfma_f32_32x32x16_bf16(pa1, PK(l1, h1), od, 0, 0, 0);
  od = __builtin_amdgcn_mfma_f32_32x32x16_bf16(pa2, PK(l2, h2), od, 0, 0, 0);
  od = __builtin_amdgcn_mfma_f32_32x32x16_bf16(pa3, PK(l3, h3), od, 0, 0, 0);
#undef PK
}
__device__ __forceinline__ void pv_d0(f32x16* o, int vb, bf16x8 pa0, bf16x8 pa1, bf16x8 pa2, bf16x8 pa3) {
  pv_one<0>(o[0], vb, pa0, pa1, pa2, pa3); pv_one<1>(o[1], vb, pa0, pa1, pa2, pa3); pv_one<2>(o[2], vb, pa0, pa1, pa2, pa3); pv_one<3>(o[3], vb, pa0, pa1, pa2, pa3);
}
template <bool ST>
__device__ __forceinline__ void attn_dense_body(float negBC, const bf16_t* __restrict__ Qb, const bf16_t* __restrict__ Kh, const bf16_t* __restrict__ Vh,
                                                bf16_t* __restrict__ Ob, int seq, LAS unsigned char* lds, LAS unsigned char* scr, int wave_id) {
  const int tid = opaque_tid(wave_id), wid = wave_id, lane = tid & 63, r32 = lane & 31, hi = lane >> 5;
  LAS float* ws = (LAS float*)scr + wid * 64; LAS float* li_l = ws; LAS float* al_l = ws + 32;
  float m_reg = -1e30f, l_reg = 0; f32x16 o[4] = {}; bf16x8 qr[8];
  const bf16_t* Qw = Qb + (long)(wid * QBLK + r32) * LDQ + hi * 8;
#pragma unroll
  for (int d0 = 0; d0 < 8; ++d0) qr[d0] = *reinterpret_cast<const bf16x8*>(Qw + d0 * 16);
  unsigned offK[2], offV[2];
#pragma unroll
  for (int i = 0; i < 2; ++i) { const int b = (i * 8 + wid) * 1024 + lane * 16;
    { const int row = b >> 8, colB = (b & 255) ^ ((row & 7) << 4); offK[i] = (unsigned)(row * LDK * 2 + colB); }
    { const int sub = b >> 9, within = b & 511, kk = (sub >> 2) * 8 + (within >> 6), k = (kk & ~0xC) | ((kk & 4) << 1) | ((kk & 8) >> 1), c = (sub & 3) * 32 + (within & 63) / 2;
      offV[i] = (unsigned)((k * LDK + c) * 2); } }
  const int vb0 = (int)(uintptr_t)(lds + 16384) + v_rd_base(lane);
#define AISSUE(t) do { const int _sl = (t) & 3; const char* _kp = (const char*)Kh + (size_t)(t) * (KVBLK * LDK * 2); const char* _vp = (const char*)Vh + (size_t)(t) * (KVBLK * LDK * 2); \
    _Pragma("unroll") for (int _i = 0; _i < 2; ++_i) { \
      __builtin_amdgcn_global_load_lds((const unsigned*)(_kp + offK[_i]), (LAS unsigned*)(lds + _sl * 32768 + (_i * 8 + wid) * 1024), 16, 0, 0); \
      __builtin_amdgcn_global_load_lds((const unsigned*)(_vp + offV[_i]), (LAS unsigned*)(lds + _sl * 32768 + 16384 + (_i * 8 + wid) * 1024), 16, 0, 0); } } while (0)
#define KPTR(t) ((const LAS unsigned char*)(lds + ((t) & 3) * 32768))
#define VBASE(t) (vb0 + ((t) & 3) * 32768)
#define WAITV4() asm volatile("s_waitcnt vmcnt(4)" ::: "memory")
#define WAITV0() asm volatile("s_waitcnt vmcnt(0)" ::: "memory")
#define RESC(a) do { if (!ST && __any((a) < 1.f)) { if (hi == 0) al_l[r32] = (a); asm volatile("s_waitcnt lgkmcnt(0)" ::: "memory"); \
    for (int d = 0; d < 4; ++d) for (int r = 0; r < 16; ++r) o[d][r] *= al_l[crow(r, hi)]; } } while (0)
  f32x16 pA0, pA1, pB0, pB1; float mnA, mnB, alA, alB; bf16x8 pa0, pa1, pa2, pa3; const int NT = seq / KVBLK;
  AISSUE(0); AISSUE(1);
  WAITV4(); RAW_BAR();
  AISSUE(2);
  qkt(pA0, pA1, KPTR(0), qr, r32, hi); partialSM<ST>(pA0, pA1, m_reg, mnA, alA, negBC);
  for (int j = 1; j + 1 < NT; j += 2) {
    WAITV4(); RAW_BAR();
    AISSUE(j + 2);
    SBAR(); qkt(pB0, pB1, KPTR(j), qr, r32, hi);
    finishSM(pA0, pA1, alA, l_reg, pa0, pa1, pa2, pa3); SBAR();
    pv_d0(o, VBASE(j - 1), pa0, pa1, pa2, pa3); partialSM<ST>(pB0, pB1, m_reg, mnB, alB, negBC);
    RESC(alB);
    WAITV4(); RAW_BAR();
    if (j + 3 < NT) AISSUE(j + 3);
    SBAR(); qkt(pA0, pA1, KPTR(j + 1), qr, r32, hi);
    finishSM(pB0, pB1, alB, l_reg, pa0, pa1, pa2, pa3); SBAR();
    pv_d0(o, VBASE(j), pa0, pa1, pa2, pa3); partialSM<ST>(pA0, pA1, m_reg, mnA, alA, negBC);
    RESC(alA);
  }
  WAITV0(); RAW_BAR();
  SBAR(); qkt(pB0, pB1, KPTR(NT - 1), qr, r32, hi);
  finishSM(pA0, pA1, alA, l_reg, pa0, pa1, pa2, pa3); SBAR();
  pv_d0(o, VBASE(NT - 2), pa0, pa1, pa2, pa3); partialSM<ST>(pB0, pB1, m_reg, mnB, alB, negBC);
  RESC(alB);
  finishSM(pB0, pB1, alB, l_reg, pa0, pa1, pa2, pa3); SBAR();
  pv_d0(o, VBASE(NT - 1), pa0, pa1, pa2, pa3);
  if (hi == 0) li_l[r32] = l_reg; asm volatile("s_waitcnt lgkmcnt(0)" ::: "memory");
  float rli[16];
#pragma unroll
  for (int r = 0; r < 16; ++r) rli[r] = __builtin_amdgcn_rcpf(li_l[crow(r, hi)]);
  bf16_t* Ow = Ob + (long)(wid * QBLK) * LDO;
#pragma unroll
  for (int r = 0; r < 16; ++r) { int orow = crow(r, hi);
    for (int d0 = 0; d0 < 4; ++d0) Ow[(long)orow * LDO + d0 * 32 + r32] = (bf16_t)f2bf(o[d0][r] * rli[r]); }
#undef AISSUE
#undef KPTR
#undef VBASE
#undef WAITV4
#undef WAITV0
#undef RESC
}

#define KSWZ16(row, colB) ((row) * 256 + ((colB) ^ (((row) & 15) << 4)))
typedef f32x4 S16[4][2];
constexpr int v16_off(int kk, int h, int db) { return kk * 8192 + h * 4096 + db * 256; }
__device__ __forceinline__ void qkt16(S16& s, const LAS unsigned char* Ks, const bf16x8 (&qf)[2][4], const int (&kb_dk)[4]) {
#pragma unroll
  for (int kb = 0; kb < 4; ++kb) { s[kb][0] = (f32x4){0.f, 0.f, 0.f, 0.f}; s[kb][1] = (f32x4){0.f, 0.f, 0.f, 0.f}; }
#pragma unroll
  for (int dk = 0; dk < 4; ++dk)
#pragma unroll
    for (int kb = 0; kb < 4; ++kb) { const bf16x8 kf = *reinterpret_cast<const LAS bf16x8*>(Ks + kb * 4096 + kb_dk[dk]);
      s[kb][0] = __builtin_amdgcn_mfma_f32_16x16x32_bf16(kf, qf[0][dk], s[kb][0], 0, 0, 0);
      s[kb][1] = __builtin_amdgcn_mfma_f32_16x16x32_bf16(kf, qf[1][dk], s[kb][1], 0, 0, 0); }
}
__device__ __forceinline__ void partialSM16(S16& s, float negBC) {
  (void)negBC;
#pragma unroll
  for (int kb = 0; kb < 2; ++kb)
#pragma unroll
    for (int qb = 0; qb < 2; ++qb)
#pragma unroll
      for (int r = 0; r < 4; ++r) s[kb][qb][r] = __builtin_amdgcn_exp2f(s[kb][qb][r]);
}
__device__ __forceinline__ void finishSM16(S16& s, float& l0, float& l1, bf16x8 (&pa)[2][2]) {
#pragma unroll
  for (int kb = 2; kb < 4; ++kb)
#pragma unroll
    for (int qb = 0; qb < 2; ++qb)
#pragma unroll
      for (int r = 0; r < 4; ++r) s[kb][qb][r] = __builtin_amdgcn_exp2f(s[kb][qb][r]);
  f32x4 a0 = (s[0][0] + s[1][0]) + (s[2][0] + s[3][0]), a1 = (s[0][1] + s[1][1]) + (s[2][1] + s[3][1]);
  l0 += (a0[0] + a0[1]) + (a0[2] + a0[3]); l1 += (a1[0] + a1[1]) + (a1[2] + a1[3]);
#pragma unroll
  for (int qb = 0; qb < 2; ++qb)
#pragma unroll
    for (int kk = 0; kk < 2; ++kk) { const f32x4 x = s[2 * kk][qb], y = s[2 * kk + 1][qb];
      u32x4 w = {cvtpk(x[0], x[1]), cvtpk(x[2], x[3]), cvtpk(y[0], y[1]), cvtpk(y[2], y[3])}; pa[qb][kk] = *reinterpret_cast<bf16x8*>(&w); }
}
template <int KK, int DQ> __device__ __forceinline__ void pv16_quad(f32x4 (&o)[2][8], int vb, const bf16x8 (&pa)[2][2]) {
  const s16x4 l0 = tr_read<v16_off(KK, 0, 4 * DQ + 0)>(vb), h0 = tr_read<v16_off(KK, 1, 4 * DQ + 0)>(vb), l1 = tr_read<v16_off(KK, 0, 4 * DQ + 1)>(vb), h1 = tr_read<v16_off(KK, 1, 4 * DQ + 1)>(vb);
  const s16x4 l2 = tr_read<v16_off(KK, 0, 4 * DQ + 2)>(vb), h2 = tr_read<v16_off(KK, 1, 4 * DQ + 2)>(vb), l3 = tr_read<v16_off(KK, 0, 4 * DQ + 3)>(vb), h3 = tr_read<v16_off(KK, 1, 4 * DQ + 3)>(vb);
  asm volatile("s_waitcnt lgkmcnt(0)" ::: "memory"); SBAR();
#define PK(L, H) (bf16x8){L[0], L[1], L[2], L[3], H[0], H[1], H[2], H[3]}
  o[0][4 * DQ + 0] = __builtin_amdgcn_mfma_f32_16x16x32_bf16(pa[0][KK], PK(l0, h0), o[0][4 * DQ + 0], 0, 0, 0);
  o[1][4 * DQ + 0] = __builtin_amdgcn_mfma_f32_16x16x32_bf16(pa[1][KK], PK(l0, h0), o[1][4 * DQ + 0], 0, 0, 0);
  o[0][4 * DQ + 1] = __builtin_amdgcn_mfma_f32_16x16x32_bf16(pa[0][KK], PK(l1, h1), o[0][4 * DQ + 1], 0, 0, 0);
  o[1][4 * DQ + 1] = __builtin_amdgcn_mfma_f32_16x16x32_bf16(pa[1][KK], PK(l1, h1), o[1][4 * DQ + 1], 0, 0, 0);
  o[0][4 * DQ + 2] = __builtin_amdgcn_mfma_f32_16x16x32_bf16(pa[0][KK], PK(l2, h2), o[0][4 * DQ + 2], 0, 0, 0);
  o[1][4 * DQ + 2] = __builtin_amdgcn_mfma_f32_16x16x32_bf16(pa[1][KK], PK(l2, h2), o[1][4 * DQ + 2], 0, 0, 0);
  o[0][4 * DQ + 3] = __builtin_amdgcn_mfma_f32_16x16x32_bf16(pa[0][KK], PK(l3, h3), o[0][4 * DQ + 3], 0, 0, 0);
  o[1][4 * DQ + 3] = __builtin_amdgcn_mfma_f32_16x16x32_bf16(pa[1][KK], PK(l3, h3), o[1][4 * DQ + 3], 0, 0, 0);
#undef PK
}
__device__ __forceinline__ void pv16(f32x4 (&o)[2][8], int vb, const bf16x8 (&pa)[2][2]) {
  pv16_quad<0, 0>(o, vb, pa); pv16_quad<0, 1>(o, vb, pa); pv16_quad<1, 0>(o, vb, pa); pv16_quad<1, 1>(o, vb, pa);
}
__device__ __forceinline__ void attn_body16(float negBC, const bf16_t* __restrict__ Qb, const bf16_t* __restrict__ Kh, const bf16_t* __restrict__ Vh,
                                            bf16_t* __restrict__ Ob, int seq, LAS unsigned char* lds, LAS unsigned char* scr, int wave_id) {
  const int tid = opaque_tid(wave_id), wid = wave_id, lane = tid & 63, c = lane & 15, g = lane >> 4;
  f32x4 o[2][8];
#pragma unroll
  for (int qb = 0; qb < 2; ++qb)
#pragma unroll
    for (int db = 0; db < 8; ++db) o[qb][db] = (f32x4){0.f, 0.f, 0.f, 0.f};
  float l0 = 0.f, l1 = 0.f;
  unsigned offK[2], offV[2];
#pragma unroll
  for (int i = 0; i < 2; ++i) { const int b = (i * 8 + wid) * 1024 + lane * 16;
    { const int row = b >> 8, colB = (b & 255) ^ ((row & 15) << 4); offK[i] = (unsigned)(row * LDK * 2 + colB); }
    { const int sub = b >> 8, within = b & 255, key = (sub >> 3) * 8 + ((within >> 5) & 1) * 4 + (within >> 6), col = (sub & 7) * 16 + (within & 31) / 2;
      offV[i] = (unsigned)((key * LDK + col) * 2); } }
  int kb_dk[4];
#pragma unroll
  for (int dk = 0; dk < 4; ++dk) kb_dk[dk] = c * 256 + (((4 * dk + g) ^ c) << 4);
  const int vb0 = (int)(uintptr_t)(lds + 16384) + (g >> 1) * 2048 + ((lane >> 2) & 3) * 64 + (g & 1) * 32 + (lane & 3) * 8;
#define AISSUE(t) do { const int _sl = (t) & 3; const char* _kp = (const char*)Kh + (size_t)(t) * (KVBLK * LDK * 2); const char* _vp = (const char*)Vh + (size_t)(t) * (KVBLK * LDK * 2); \
    _Pragma("unroll") for (int _i = 0; _i < 2; ++_i) { \
      __builtin_amdgcn_global_load_lds((const unsigned*)(_kp + offK[_i]), (LAS unsigned*)(lds + _sl * 32768 + (_i * 8 + wid) * 1024), 16, 0, 0); \
      __builtin_amdgcn_global_load_lds((const unsigned*)(_vp + offV[_i]), (LAS unsigned*)(lds + _sl * 32768 + 16384 + (_i * 8 + wid) * 1024), 16, 0, 0); } } while (0)
#define KPTR(t) ((const LAS unsigned char*)(lds + ((t) & 3) * 32768))
#define VBASE(t) (vb0 + ((t) & 3) * 32768)
#define WAITV4() asm volatile("s_waitcnt vmcnt(4)" ::: "memory")
#define WAITV0() asm volatile("s_waitcnt vmcnt(0)" ::: "memory")
  S16 sA, sB; bf16x8 pa[2][2]; const int NT = seq / KVBLK;
  AISSUE(0); AISSUE(1);
  bf16x8 qf[2][4];
#pragma unroll
  for (int qb = 0; qb < 2; ++qb)
#pragma unroll
    for (int dk = 0; dk < 4; ++dk) { const u32x4 w = *reinterpret_cast<const u32x4*>(Qb + (long)(wid * 32 + 16 * qb + c) * LDQ + 32 * dk + 8 * g);
      constexpr float C = SCALE * 1.4426950408889634f; u32x4 v;
#pragma unroll
      for (int e = 0; e < 4; ++e) { const float lo = __uint_as_float(w[e] << 16), hi = __uint_as_float(w[e] & 0xffff0000u); v[e] = (cvtpk(lo * C, hi * C) + 0x00080008u) & 0xFFF0FFF0u; }
      qf[qb][dk] = *reinterpret_cast<const bf16x8*>(&v); }
  WAITV0(); RAW_BAR();
  AISSUE(2);
  qkt16(sA, KPTR(0), qf, kb_dk); partialSM16(sA, negBC);
  if (wid >= 4) __builtin_amdgcn_s_setprio(1);
  for (int j = 1; j + 1 < NT; j += 2) {
    WAITV4(); RAW_BAR();
    AISSUE(j + 2);
    SBAR(); qkt16(sB, KPTR(j), qf, kb_dk);
    finishSM16(sA, l0, l1, pa); SBAR();
    pv16(o, VBASE(j - 1), pa); partialSM16(sB, negBC);
    WAITV4(); RAW_BAR();
    if (j + 3 < NT) AISSUE(j + 3);
    SBAR(); qkt16(sA, KPTR(j + 1), qf, kb_dk);
    finishSM16(sB, l0, l1, pa); SBAR();
    pv16(o, VBASE(j), pa); partialSM16(sA, negBC);
  }
  WAITV0(); RAW_BAR();
  SBAR(); qkt16(sB, KPTR(NT - 1), qf, kb_dk);
  finishSM16(sA, l0, l1, pa); SBAR();
  pv16(o, VBASE(NT - 2), pa); partialSM16(sB, negBC);
  finishSM16(sB, l0, l1, pa); SBAR();
  pv16(o, VBASE(NT - 1), pa);
  __builtin_amdgcn_s_setprio(0);
  LAS float* Ls = (LAS float*)scr + wid * 128;
  Ls[(0 * 16 + c) * 4 + g] = l0; Ls[(1 * 16 + c) * 4 + g] = l1;
  asm volatile("s_waitcnt lgkmcnt(0)" ::: "memory");
#pragma unroll
  for (int qb = 0; qb < 2; ++qb)
#pragma unroll
    for (int r = 0; r < 4; ++r) { const f32x4 t = *reinterpret_cast<const LAS f32x4*>(&Ls[(qb * 16 + 4 * g + r) * 4]);
      const float rl = __builtin_amdgcn_rcpf((t[0] + t[1]) + (t[2] + t[3]));
      bf16_t* orow = Ob + (long)(wid * 32 + 16 * qb + 4 * g + r) * LDO + c;
#pragma unroll
      for (int db = 0; db < 8; ++db) orow[16 * db] = (bf16_t)f2bf(o[qb][db][r] * rl); }
  asm volatile("s_waitcnt lgkmcnt(0)" ::: "memory");
#undef AISSUE
#undef KPTR
#undef VBASE
#undef WAITV4
#undef WAITV0
}

__device__ __forceinline__ void dft_task(const bf16_t* __restrict__ src, long row0, int rstride, int NTlog, const bf16_t* __restrict__ F, int frow0, int ch,
                                         LAS unsigned char* vl, int lane, f32x16 (&o)[4]) {
  const int r32 = lane & 31, hi = lane >> 5, NT = 1 << NTlog, K = 2 * NT, ntile = K / 64;
  const int vb = (int)(uintptr_t)vl + v_rd_base(lane);
  const int cc = (lane & 15) * 8, key0 = lane >> 4;
#pragma unroll
  for (int d = 0; d < 4; ++d) o[d] = f32x16{};
  u32x4 st[16];
#define DFT_LOAD1(dst, kt_, i) do { const int kg = (kt_) * 64 + 4 * (i) + key0, ri = kg >> NTlog, tt = kg & (NT - 1); \
      dst = *(const u32x4*)(src + (size_t)(row0 + (long)tt * rstride) * 512 + ri * 256 + ch * 128 + cc); } while (0)
#pragma unroll
  for (int i = 0; i < 16; ++i) DFT_LOAD1(st[i], 0, i);
  for (int kt = 0; kt < ntile; ++kt) {
    constexpr int NPF = 6;
    u32x4 na[NPF];
    const bool more = kt + 1 < ntile;
    if (more) {
#pragma unroll
      for (int i = 0; i < NPF; ++i) DFT_LOAD1(na[i], kt + 1, i);
    }
    const bf16_t* Fp = F + (size_t)(frow0 + r32) * K + kt * 64 + 8 * hi;
    const bf16x8 pa0 = *(const bf16x8*)(Fp), pa1 = *(const bf16x8*)(Fp + 16), pa2 = *(const bf16x8*)(Fp + 32), pa3 = *(const bf16x8*)(Fp + 48);
#pragma unroll
    for (int i = 0; i < 16; ++i) *(LAS u32x4*)(vl + v_st(4 * i + key0, cc)) = st[i];
    asm volatile("s_waitcnt lgkmcnt(0)" ::: "memory");
    pv_d0(o, vb, pa0, pa1, pa2, pa3);
    if (more) {
#pragma unroll
      for (int i = 0; i < NPF; ++i) st[i] = na[i];
#pragma unroll
      for (int i = NPF; i < 16; ++i) DFT_LOAD1(st[i], kt + 1, i);
    }
  }
#undef DFT_LOAD1
}
}


#define XB_TMO      128
#define XB_XCNT(j)  (256  + 64 * (j))
#define XB_XSUB(j)  (1280 + 64 * (j))
#define XB_XGEN(j)  (2304 + 64 * (j))
#define XB_TOP      3328
#define XB_TOPGEN   3392
#define XCD_BAR_WORDS 3456
#define XB_SPIN_CAP (1u << 22)
__device__ __forceinline__ unsigned xb_ld(unsigned* p)              { return __hip_atomic_load(p, __ATOMIC_RELAXED, __HIP_MEMORY_SCOPE_AGENT); }
__device__ __forceinline__ unsigned xb_add(unsigned* p, unsigned v) { return __hip_atomic_fetch_add(p, v, __ATOMIC_RELAXED, __HIP_MEMORY_SCOPE_AGENT); }
__device__ __forceinline__ unsigned xb_xcc_id() { return (unsigned)__builtin_amdgcn_s_getreg((3 << 11) | 20) & 0xFu; }
#define XB_SPIN(cond, bar) do { unsigned _sp = 0; while (cond) { __builtin_amdgcn_s_sleep(1); \
    if ((++_sp & 255u) == 0u) { if (xb_ld(&(bar)[XB_TMO])) break; if (_sp > XB_SPIN_CAP) { atomicAdd(&(bar)[XB_TMO], 1u); break; } } } } while (0)
struct XcdBarrier { unsigned* bar; unsigned x; volatile LAS unsigned* st; };
__device__ __forceinline__ XcdBarrier xcd_barrier_post(unsigned* bar, volatile LAS unsigned* st) {
    XcdBarrier b; b.bar = bar; b.x = xb_xcc_id(); b.st = st;
    if (threadIdx.x == 0) (void)xb_add(&bar[XB_XCNT(b.x)], 1u);
    return b;
}
__device__ __forceinline__ void xcd_barrier_complete(unsigned* bar, unsigned x, unsigned& nloc, unsigned& nx) {
    const unsigned G = gridDim.x * gridDim.y * gridDim.z;
    unsigned sum, cnt, mine, sp = 0u;
    for (;;) {
        sum = 0u; cnt = 0u; mine = 0u;
#pragma unroll
        for (unsigned j = 0; j < 16; ++j) { const unsigned c = xb_ld(&bar[XB_XCNT(j)]); sum += c; cnt += (c > 0u) ? 1u : 0u; mine = (j == x) ? c : mine; }
        if (sum == G) break;
        __builtin_amdgcn_s_sleep(1);
        if ((++sp & 255u) == 0u) { if (xb_ld(&bar[XB_TMO])) break; if (sp > XB_SPIN_CAP) { atomicAdd(&bar[XB_TMO], 1u); break; } }
    }
    nloc = mine > 0u ? mine : 1u; nx = cnt > 0u ? cnt : 1u;
}
__device__ __forceinline__ void xcd_barrier(const XcdBarrier& b) {
    asm volatile("s_waitcnt vmcnt(0)" ::: "memory");
    __syncthreads();
    if (threadIdx.x == 0) {
        unsigned* bar = b.bar;
        __builtin_amdgcn_s_waitcnt(0);
        unsigned nloc = b.st[0], nx = b.st[1];
        if (nloc == 0u) { xcd_barrier_complete(bar, b.x, nloc, nx); b.st[0] = nloc; b.st[1] = nx; }
        const unsigned old = xb_add(&bar[XB_XSUB(b.x)], 1u);
        const unsigned gen = old / nloc;
        if (old + 1u == (gen + 1u) * nloc) {
            __builtin_amdgcn_fence(__ATOMIC_RELEASE, "agent");
            asm volatile("s_waitcnt vmcnt(0)" ::: "memory");
            const unsigned og = xb_add(&bar[XB_TOP], 1u);
            const unsigned tg = og / nx;
            if (og + 1u == (tg + 1u) * nx) xb_add(&bar[XB_TOPGEN], 1u);
            else XB_SPIN(xb_ld(&bar[XB_TOPGEN]) == tg, bar);
            __builtin_amdgcn_fence(__ATOMIC_ACQUIRE, "agent");
            xb_add(&bar[XB_XGEN(b.x)], 1u);
            asm volatile("s_waitcnt vmcnt(0)" ::: "memory");
        } else {
            XB_SPIN(xb_ld(&bar[XB_XGEN(b.x)]) == gen, bar);
            __builtin_amdgcn_fence(__ATOMIC_ACQUIRE, "agent");
            asm volatile("s_waitcnt vmcnt(0)" ::: "memory");
        }
    }
    __syncthreads();
}
__device__ __forceinline__ int perm_headdim(int e) { return 32 * (2 * (e >> 6) + ((e & 31) >> 4)) + 8 * (((e & 31) >> 2) & 3) + 4 * ((e >> 5) & 1) + (e & 3); }
template <int MAP>
__device__ __forceinline__ void tr_item(const float* __restrict__ W, int ldw, int ncols, int K, const float* __restrict__ gk, bf16_t* WT, LAS float* scr, int item, int lane) {
    const int nblk = ncols / 32, kb = item / nblk, nb = item % nblk, k0 = 64 * kb, n0 = 32 * nb;
    float tv[32];
#pragma unroll
    for (int i = 0; i < 32; ++i) { const int kk = 2 * i + (lane >> 5); tv[i] = W[(size_t)(k0 + kk) * ldw + n0 + (lane & 31)]; }
#pragma unroll
    for (int i = 0; i < 32; ++i) { const int kk = 2 * i + (lane >> 5); float v = tv[i]; if (gk) v *= gk[k0 + kk]; scr[kk * 33 + (lane & 31)] = v; }
    LDS_WAIT(); asm volatile("" ::: "memory");
    const int c = lane & 7;
#pragma unroll
    for (int j = 0; j < 4; ++j) { const int n = (lane >> 3) + 8 * j; const LAS float* s = scr + (8 * c) * 33 + n;
        u32x4 o; o.x = pk2(s[0 * 33], s[1 * 33]); o.y = pk2(s[2 * 33], s[3 * 33]); o.z = pk2(s[4 * 33], s[5 * 33]); o.w = pk2(s[6 * 33], s[7 * 33]);
        int dn = n0 + n;
        if (MAP == 1) { dn = dn < 1024 ? 512 + (dn & ~127) + perm_headdim(dn & 127) : 512 + dn; }
        *(u32x4*)(WT + (size_t)dn * K + k0 + 8 * c) = o; }
    LDS_WAIT(); asm volatile("" ::: "memory");
}
template <int NR>
__device__ __forceinline__ void rms_rows_to_bf16(const float* const (&xrow)[NR], const float* __restrict__ g, bf16_t* const (&orow)[NR], int lane) {
    const f32x4* gr = (const f32x4*)g + lane;
    f32x4 v[NR][4];
#pragma unroll
    for (int r = 0; r < NR; ++r)
#pragma unroll
        for (int j = 0; j < 4; ++j) v[r][j] = ((const f32x4*)xrow[r] + lane)[64 * j];
#pragma unroll
    for (int r = 0; r < NR; ++r) { float s = 0.f;
#pragma unroll
        for (int j = 0; j < 4; ++j) s += pg8::dot4(v[r][j]);
        const float rstd = rsqrtf(wave_sum(s) * (1.f / DM) + EPS);
        unsigned long long* o8 = (unsigned long long*)orow[r] + lane;
#pragma unroll
        for (int j = 0; j < 4; ++j) { const f32x4 gg = gr[64 * j]; const f32x4 y = v[r][j] * rstd * gg;
            o8[64 * j] = (unsigned long long)pk2(y[0], y[1]) | ((unsigned long long)pk2(y[2], y[3]) << 32); } }
}
__device__ __forceinline__ float f1_val(int rg, int k, int N1) {
    const int w = rg >> 5, rho = rg & 31, j = rho & 3, hi = (rho >> 2) & 1, q = rho >> 3, ri = q & 1, s1 = 16 * w + 8 * (q >> 1) + 4 * hi + j;
    const int rip = k / N1, t1 = k % N1, m = (s1 * t1) % N1; const float a = 2.f * (float)m / (float)N1; const float c = cospif(a), s = sinpif(a);
    return ri == 0 ? (rip == 0 ? c : s) : (rip == 0 ? -s : c);
}
__device__ __forceinline__ float f2_val(int s2, int k, int N2, float inv) {
    const int ri = k / N2, t2 = k % N2, m = (s2 * t2) % N2; const float a = 2.f * (float)m / (float)N2; return (ri == 0 ? cospif(a) : sinpif(a)) * inv;
}

struct Params { const float* in[20]; float* out; unsigned char* ws; };

__global__ void __launch_bounds__(512, 2) mega_fwd(Params p) {
    extern __shared__ __attribute__((aligned(16))) unsigned char lds_raw[];
    cg::grid_group grid = cg::this_grid();
    LAS unsigned char* lds = (LAS unsigned char*)lds_raw;
    LAS unsigned char* elds = lds + ELDS_OFF;
    const int tid = threadIdx.x, lane = tid & 63, wave = __builtin_amdgcn_readfirstlane(tid >> 6);
    const int G = gridDim.x, cb = blockIdx.x, gw = cb * 8 + wave, NGW = G * 8;
    unsigned char* ws = p.ws;
    const float *x_p = p.in[0], *x_s = p.in[1], *mem_p = p.in[2], *mem_s = p.in[3], *g_mix = p.in[4], *w_in = p.in[5], *w_f = p.in[6], *g_q = p.in[7], *g_k = p.in[8],
                *w_out = p.in[9], *g_cross = p.in[10], *g_mem = p.in[11], *w_cq = p.in[12], *w_ckv = p.in[13], *g_cq = p.in[14], *g_ck = p.in[15], *w_co = p.in[16],
                *g_mlp = p.in[17], *w_up = p.in[18], *w_down = p.in[19];
    float* out = p.out;
    if (tid < 8) ((LAS unsigned*)(lds + MISC_OFF))[tid] = 0u;
    __syncthreads();
    const XcdBarrier xbar = xcd_barrier_post((unsigned*)(ws + WS_BAR), (volatile LAS unsigned*)(lds + MISC_OFF));
#define GRID_BAR() xcd_barrier(xbar)
#define WSP(T, off) ((T*)(ws_launder(ws) + (off)))
#define SS2 WSP(float, WS_SS2)
#define SS3 WSP(float, WS_SS3)
#define ROPE WSP(float, WS_ROPE)
#define F1P WSP(bf16_t, WS_F1P)
#define F2P WSP(bf16_t, WS_F2P)
#define F1S WSP(bf16_t, WS_F1S)
#define F2S WSP(bf16_t, WS_F2S)
#define WIN WSP(bf16_t, WS_WIN)
#define WOUT WSP(bf16_t, WS_WOUT)
#define WCQ WSP(bf16_t, WS_WCQ)
#define WCKV WSP(bf16_t, WS_WCKV)
#define WCO WSP(bf16_t, WS_WCO)
#define WUP WSP(bf16_t, WS_WUP)
#define WDN WSP(bf16_t, WS_WDN)
#define MN WSP(bf16_t, WS_MN)
#define KC WSP(bf16_t, WS_KC)
#define VT WSP(bf16_t, WS_VT)
#define XN1 WSP(bf16_t, WS_XN1)
#define PB WSP(bf16_t, WS_PB)
#define TMP WSP(bf16_t, WS_TMP)
#define QB WSP(bf16_t, WS_QB)
#define KB WSP(bf16_t, WS_KB)
#define VB WSP(bf16_t, WS_VB)
#define MIX WSP(bf16_t, WS_MIX)
#define XB2 WSP(bf16_t, WS_XB2)
#define QC WSP(bf16_t, WS_QC)
#define PC WSP(bf16_t, WS_PC)
#define OC WSP(bf16_t, WS_OC)
#define XB3 WSP(bf16_t, WS_XB3)
#define HB WSP(bf16_t, WS_H)


    {
        if (cb < 32) {
            const int g = cb >> 3, ri = (cb >> 2) & 1, kq = cb & 3;
            LAS float* Wf_s = (LAS float*)lds; LAS float* M_s = (LAS float*)(lds + 16384); LAS float* T_s = (LAS float*)(lds + 16384 + 64 * 65 * 4);
            for (int i = tid; i < 4096; i += 512) Wf_s[i] = w_f[g * 4096 + i];
            if (tid < 64) { const float a = (float)tid / 32.f; T_s[tid] = ri == 0 ? cospif(a) * 0.125f : -sinpif(a) * 0.125f; }
            __syncthreads();
            { const int cp = tid >> 3, d0 = (tid & 7) * 8; float accm[8];
#pragma unroll
              for (int d = 0; d < 8; ++d) accm[d] = 0.f;
              for (int c = 0; c < 64; ++c) { const float t = T_s[(c * cp) & 63];
#pragma unroll
                  for (int d = 0; d < 8; ++d) accm[d] += t * Wf_s[c * 64 + d0 + d]; }
#pragma unroll
              for (int d = 0; d < 8; ++d) M_s[cp * 65 + d0 + d] = accm[d]; }
            __syncthreads();
            { const int k = kq * 256 + wave * 32 + (lane & 31), dh = lane >> 5; float wrow[64];
              const f32x4* wp = (const f32x4*)(w_in + (size_t)k * 1536 + g * 64);
#pragma unroll
              for (int i = 0; i < 16; ++i) { const f32x4 t = wp[i]; wrow[4 * i] = t[0]; wrow[4 * i + 1] = t[1]; wrow[4 * i + 2] = t[2]; wrow[4 * i + 3] = t[3]; }
              for (int d = 0; d < 32; ++d) { float a = 0.f;
#pragma unroll
                  for (int c = 0; c < 64; ++c) a += wrow[c] * M_s[c * 65 + 32 * dh + d];
                  WIN[(size_t)(ri * 256 + g * 64 + 32 * dh + d) * 1024 + k] = (bf16_t)f2bf(a); } }
        }
        __syncthreads();
        LAS float* scr = (LAS float*)(lds + wave * 16384);
        constexpr int I_IN = 40 * 16, I_SQ = 32 * 16, I_CKV = 64 * 16, I_UP = 128 * 16, I_DN = 32 * 64;
        constexpr int NITEMS = I_IN + 3 * I_SQ + I_CKV + I_UP + I_DN;
        for (int it = gw; it < NITEMS; it += NGW) {
            int r = it;
            if (r < I_IN) { tr_item<1>(w_in + 256, 1536, 1280, 1024, nullptr, WIN, scr, r, lane); continue; } r -= I_IN;
            if (r < I_SQ) { tr_item<0>(w_out, 1024, 1024, 1024, nullptr, WOUT, scr, r, lane); continue; } r -= I_SQ;
            if (r < I_SQ) { tr_item<0>(w_cq, 1024, 1024, 1024, g_cross, WCQ, scr, r, lane); continue; } r -= I_SQ;
            if (r < I_SQ) { tr_item<0>(w_co, 1024, 1024, 1024, nullptr, WCO, scr, r, lane); continue; } r -= I_SQ;
            if (r < I_CKV) { tr_item<0>(w_ckv, 2048, 2048, 1024, nullptr, WCKV, scr, r, lane); continue; } r -= I_CKV;
            if (r < I_UP) { tr_item<0>(w_up, 4096, 4096, 1024, g_mlp, WUP, scr, r, lane); continue; } r -= I_UP;
            tr_item<0>(w_down, 1024, 1024, 4096, nullptr, WDN, scr, r, lane);
        }
        for (int m = gw; m < TT; m += 4 * NGW) {
            if (m + 3 * NGW < TT) {
                const float* xr[4]; bf16_t* orw[4];
#pragma unroll
                for (int r = 0; r < 4; ++r) { const int mr = m + r * NGW; xr[r] = mr < TP ? x_p + (size_t)mr * DM : x_s + (size_t)(mr - TP) * DM; orw[r] = XN1 + (size_t)mr * DM; }
                rms_rows_to_bf16<4>(xr, g_mix, orw, lane);
            } else {
                for (int mr = m; mr < TT; mr += NGW) { const float* xr[1] = {mr < TP ? x_p + (size_t)mr * DM : x_s + (size_t)(mr - TP) * DM}; bf16_t* orw[1] = {XN1 + (size_t)mr * DM};
                    rms_rows_to_bf16<1>(xr, g_mix, orw, lane); }
            }
        }
        for (int mm = gw; mm < NMEMROWS; mm += NGW) { const float* xr[1] = {mm < 256 ? mem_p + (size_t)mm * DM : mem_s + (size_t)(mm - 256) * DM}; bf16_t* orw[1] = {MN + (size_t)mm * DM};
            rms_rows_to_bf16<1>(xr, g_mem, orw, lane); }
        for (int i = cb * 512 + tid; i < 118784 + 98304; i += G * 512) {
            int r = i;
            if (r < 65536) { F1P[r] = (bf16_t)f2bf(f1_val(r >> 8, r & 255, 128)); continue; } r -= 65536;
            if (r < 32768) { F2P[r] = (bf16_t)f2bf(f2_val(r >> 8, r & 255, 128, 0.0078125f)); continue; } r -= 32768;
            if (r < 4096) { F1S[r] = (bf16_t)f2bf(f1_val(r >> 6, r & 63, 32)); continue; } r -= 4096;
            if (r < 8192) { F2S[r] = (bf16_t)f2bf(f2_val(r >> 7, r & 127, 64, 0.022097086912079608f)); continue; } r -= 8192;
            if (r < 8192) { const int v = r >> 5, j = r & 31; const float inv = 1.0f / powf(10000.f, (float)(2 * j) / 64.f); const float ang = (float)v * inv;
                ROPE[2 * r] = cosf(ang); ROPE[2 * r + 1] = sinf(ang); continue; } r -= 8192;
            SS2[r] = 0.f;
        }
    }
    grid.sync();

    {
        pg8::PolP1 S{(const char*)ws, G, cb};
        pg8::EpiP1 E{PB, QB, KB, VB, KC, VT, g_q, g_k, g_ck, ROPE};
        pg8::gemm_phase(wave, lds, elds, S, E, 1024, 1024, 1024);
    }
    GRID_BAR();

    {
        const int tl = opaque_tid(wave), lane = tl & 63;
        LAS unsigned char* vl = lds + wave * 16384;
        const int r32 = lane & 31, hi = lane >> 5;
        for (int tau = gw; tau < 2048 + 4096; tau += NGW) {
            int ch, w, t2, N2, Slog; long base; const bf16_t* F; int NTlog;
            if (tau < 2048) { ch = tau & 1; w = (tau >> 1) & 7; t2 = tau >> 4; base = 0; N2 = 128; Slog = 14; F = F1P; NTlog = 7; }
            else { const int t = tau - 2048; ch = t & 1; w = (t >> 1) & 1; t2 = (t >> 2) & 63; base = TP + (long)(t >> 8) * SS_LEN; N2 = 64; Slog = 11; F = F1S; NTlog = 5; }
            f32x16 o[4];
            att::dft_task(PB, base + t2, N2, NTlog, F, 32 * w, ch, vl, lane, o);
#pragma unroll
            for (int pp = 0; pp < 2; ++pp)
#pragma unroll
                for (int j = 0; j < 4; ++j) { const int s1 = 16 * w + 8 * pp + 4 * hi + j; const int mm = (s1 * t2) & ((1 << Slog) - 1);
                    const float a = 2.f * (float)mm / (float)(1 << Slog); const float c = cospif(a), s = sinpif(a);
                    bf16_t* dp = TMP + (size_t)(base + (long)s1 * N2 + t2) * 512 + ch * 128 + r32;
#pragma unroll
                    for (int d0 = 0; d0 < 4; ++d0) { const float re = o[d0][8 * pp + j], im = o[d0][8 * pp + 4 + j];
                        dp[d0 * 32] = (bf16_t)f2bf(re * c + im * s); dp[256 + d0 * 32] = (bf16_t)f2bf(im * c - re * s); } }
        }
    }
    GRID_BAR();

    {
        const int tl = opaque_tid(wave), lane = tl & 63;
        LAS unsigned char* vl = lds + wave * 16384;
        const int r32 = lane & 31, hi = lane >> 5;
        for (int it = 0; ; ++it) {
            int tau;
            if (NGW == 2048) { if (gw < 1024) { if (it > 0) break; tau = gw; } else { if (it > 1) break; tau = gw + it * 1024; } }
            else { tau = gw + it * NGW; if (tau >= 1024 + 2048) break; }
            int ch, rb, s1, N1, N2; long base; const bf16_t* F; int NTlog;
            if (tau < 1024) { ch = tau & 1; rb = (tau >> 1) & 3; s1 = tau >> 3; base = 0; N1 = 128; N2 = 128; F = F2P; NTlog = 7; }
            else { const int t = tau - 1024; ch = t & 1; rb = (t >> 1) & 1; s1 = (t >> 2) & 31; base = TP + (long)(t >> 7) * SS_LEN; N1 = 32; N2 = 64; F = F2S; NTlog = 6; }
            f32x16 o[4];
            att::dft_task(TMP, base + (long)s1 * N2, 1, NTlog, F, 32 * rb, ch, vl, lane, o);
#pragma unroll
            for (int r = 0; r < 16; ++r) { const int s2 = 32 * rb + att::crow(r, hi); bf16_t* dp = MIX + (size_t)(base + s1 + (long)N1 * s2) * 1024 + ch * 128 + r32;
#pragma unroll
                for (int d0 = 0; d0 < 4; ++d0) dp[d0 * 32] = (bf16_t)f2bf(o[d0][r]); }
        }
        __syncthreads();
        float gqm = fmaxf(fabsf(g_q[lane]), fabsf(g_q[lane + 64])), gkm = fmaxf(fabsf(g_k[lane]), fabsf(g_k[lane + 64]));
#pragma unroll
        for (int o = 1; o < 64; o <<= 1) { gqm = fmaxf(gqm, __shfl_xor(gqm, o)); gkm = fmaxf(gkm, __shfl_xor(gkm, o)); }
        const float BC = 128.f * 1.02f * gqm * gkm * (att::SCALE * 1.4426950408889634f);
        const bool use_static = BC < 60.f;
        const float negBC = -BC;
        const int nun = (G == 256) ? (cb < 128 ? 2 : 7) : (1152 - cb + G - 1) / G;
        for (int iu = 0; iu < nun; ++iu) {
            int uidx;
            if (G == 256) { const int cc = cb - 128, xk = cc >> 3; uidx = cb < 128 ? cb + 256 * iu : (iu == 0 ? cb : 384 + (2 * (cc & 7) + (xk >> 3)) * 48 + (xk & 7) * 6 + (iu - 1)); }
            else uidx = cb + iu * G;
            long rowbase, kvbase; int h, qb, seq;
            if (uidx < 384) { h = uidx >> 6; qb = uidx & 63; rowbase = 0; kvbase = 0; seq = TP; }
            else { const int v = uidx - 384; const int b = v / 48, rem = v % 48; h = rem >> 3; qb = rem & 7; kvbase = TP + (long)b * SS_LEN; rowbase = kvbase; seq = SS_LEN; }
            const long qrow = rowbase + (long)qb * 256; const int kvh = h / 3;
            if (use_static) att::attn_body16(negBC, QB + (size_t)qrow * 768 + h * 128, KB + (size_t)kvbase * 512 + kvh * 256, KB + (size_t)kvbase * 512 + kvh * 256 + 128,
                                 MIX + (size_t)qrow * 1024 + 256 + h * 128, seq, lds, elds, wave);
            else att::attn_dense_body<false>(0.f, QB + (size_t)qrow * 768 + h * 128, KB + (size_t)kvbase * 512 + kvh * 256, KB + (size_t)kvbase * 512 + kvh * 256 + 128,
                                 MIX + (size_t)qrow * 1024 + 256 + h * 128, seq, lds, elds, wave);
            __syncthreads();
        }
    }
    GRID_BAR();

    {
        pg8::PolSimple S{MIX, WOUT, 192, 4, 1024, 1024, G, cb};
        pg8::EpiResid E{x_p, x_s, out, XB2, SS2, 0};
        pg8::gemm_phase(wave, lds, elds, S, E, 1024, 1024, 1024);
    }
    GRID_BAR();
    {
        pg8::PolSimple S{XB2, WCQ, 192, 4, 1024, 1024, G, cb};
        pg8::EpiCq E{SS2, g_cq, QC};
        pg8::gemm_phase(wave, lds, elds, S, E, 1024, 1024, 1024);
    }
    __syncthreads();
    {
        pg8::PolS S{QC, KC, G, cb};
        pg8::EpiSoftmax E{PC};
        pg8::gemm_phase(wave, lds, elds, S, E, 256, 1024, 1024);
    }
    __syncthreads();
    {
        pg8::PolPV S{PC, VT, G, cb};
        pg8::EpiPlain E{OC, 1024};
        pg8::gemm_phase(wave, lds, elds, S, E, 256, 1024, NMEMROWS);
    }
    GRID_BAR();
    {
        pg8::PolSimple S{OC, WCO, 192, 4, 1024, 1024, G, cb};
        pg8::EpiResid E{out, out + (size_t)TP * DM, out, XB3, SS3, 0};
        pg8::gemm_phase(wave, lds, elds, S, E, 1024, 1024, 1024);
    }
    GRID_BAR();
    for (int ck = 0; ck <= 3; ++ck) {
        if (ck >= 1) {
            pg8::PolSimple S{HB + (size_t)((ck - 1) & 1) * 16384 * 4096, WDN, 64, 4, 4096, 4096, G, cb};
            pg8::EpiResid E{out, out + (size_t)TP * DM, out, nullptr, nullptr, (ck - 1) * 16384};
            pg8::gemm_phase(wave, lds, elds, S, E, 4096, 4096, 4096);
        }
        if (ck < 3) {
            pg8::PolSimple S{XB3 + (size_t)ck * 16384 * DM, WUP, 64, 16, 1024, 1024, G, cb};
            pg8::EpiUp E{SS3, HB + (size_t)(ck & 1) * 16384 * 4096, ck * 16384};
            pg8::gemm_phase(wave, lds, elds, S, E, 1024, 1024, 1024);
            GRID_BAR();
        }
    }
}

#undef WSP
#undef SS2
#undef SS3
#undef ROPE
#undef F1P
#undef F2P
#undef F1S
#undef F2S
#undef WIN
#undef WOUT
#undef WCQ
#undef WCKV
#undef WCO
#undef WUP
#undef WDN
#undef MN
#undef KC
#undef VT
#undef XN1
#undef PB
#undef TMP
#undef QB
#undef KB
#undef VB
#undef MIX
#undef XB2
#undef QC
#undef PC
#undef OC
#undef XB3
#undef HB
extern "C" void kernel_launch(void* const* d_in, const int* in_sizes, int n_in, void* d_out, int out_size, void* d_ws, size_t ws_size, hipStream_t stream) {
    static int grid = 0;
    if (grid == 0) {
        if (n_in != 20 || out_size != TT * DM || ws_size < WS_NEED) { fprintf(stderr, "kernel_launch: unexpected shapes: n_in %d out %d ws %zu\n", n_in, out_size, ws_size); grid = -1; return; }
        int dev = 0, cus = 0, per_cu = 0;
        hipGetDevice(&dev); hipDeviceGetAttribute(&cus, hipDeviceAttributeMultiprocessorCount, dev);
        if (hipFuncSetAttribute((const void*)mega_fwd, hipFuncAttributeMaxDynamicSharedMemorySize, LDS_BYTES) != hipSuccess) { fprintf(stderr, "kernel_launch: hipFuncSetAttribute failed\n"); grid = -1; return; }
        if (hipOccupancyMaxActiveBlocksPerMultiprocessor(&per_cu, (const void*)mega_fwd, 512, LDS_BYTES) != hipSuccess || per_cu < 1) { fprintf(stderr, "kernel_launch: occupancy query failed (%d)\n", per_cu); grid = -1; return; }
        grid = cus;
    }
    if (grid < 0) return;
    if (hipMemsetAsync((char*)d_ws + WS_BAR, 0, BAR_BYTES, stream) != hipSuccess) { fprintf(stderr, "kernel_launch: hipMemsetAsync failed\n"); return; }
    Params p{};
    for (int i = 0; i < 20; ++i) p.in[i] = (const float*)d_in[i];
    p.out = (float*)d_out; p.ws = (unsigned char*)d_ws;
    void* args[] = {&p};
    hipError_t e = hipLaunchCooperativeKernel((const void*)mega_fwd, dim3(grid), dim3(512), args, LDS_BYTES, stream);
    if (e != hipSuccess) fprintf(stderr, "kernel_launch: cooperative launch failed: %s (grid %d)\n", hipGetErrorString(e), grid);
}
```
